# Optimizing an MI355X kernel written in HIP

```python
import math
import jax, jax.numpy as jnp
from jax import lax
import numpy as np

D_MODEL = 1024
BATCH = 4
SEQ = 4096
DEPTH = 2

ATT_HEADS = 8
ATT_KV_HEADS = 2
ATT_HEAD_DIM = 64
ATT_WIDTH = ATT_HEADS * ATT_HEAD_DIM
WINDOW = 128
ATT_BLOCK = 128
N_BUCKETS = 32
MAX_DISTANCE = 128
ML_HEADS = 4
ML_DQK = 64
ML_DV = 128
ML_WIDTH = ML_HEADS * ML_DV
ML_CHUNK = 64
CONV_K = 4
D_MIX = ATT_WIDTH + ML_WIDTH
IN_SPLITS = [ATT_WIDTH, ATT_KV_HEADS * ATT_HEAD_DIM, ATT_KV_HEADS * ATT_HEAD_DIM,
             ML_HEADS * ML_DQK, ML_HEADS * ML_DQK, ML_WIDTH, ML_WIDTH, ML_HEADS, ML_HEADS]
N_IN = sum(IN_SPLITS)
SPLIT_POINTS = [int(v) for v in np.cumsum(IN_SPLITS)[:-1]]
N_GROUPS = 4
EXPERTS_PER_GROUP = 4
N_EXPERTS = N_GROUPS * EXPERTS_PER_GROUP
TOP_K = 2
D_FF_EXPERT = 512
EPS = 1e-6

kernel_name = "hymba_swa_mlstm_hier_moe"


def rms_norm(x, g):
    xf = x.astype(jnp.float32)
    y = xf * lax.rsqrt(jnp.mean(xf * xf, axis=-1, keepdims=True) + EPS)
    return (y * g.astype(jnp.float32)).astype(x.dtype)


def t5_bucket(dist):
    max_exact = N_BUCKETS // 2
    d = jnp.maximum(dist, 1).astype(jnp.float32)
    large = max_exact + (jnp.log(d / max_exact) / math.log(MAX_DISTANCE / max_exact)
                         * (N_BUCKETS - max_exact)).astype(jnp.int32)
    large = jnp.minimum(large, N_BUCKETS - 1)
    return jnp.where(dist < max_exact, dist, large)


def swa_sink_attention(q, k, v, q_g, k_g, sink, rel_bias):
    B, S, _ = q.shape
    nb = S // ATT_BLOCK
    G = ATT_HEADS // ATT_KV_HEADS
    q = rms_norm(q.reshape(B, S, ATT_HEADS, ATT_HEAD_DIM), q_g)
    k = rms_norm(k.reshape(B, S, ATT_KV_HEADS, ATT_HEAD_DIM), k_g)
    v = v.reshape(B, S, ATT_KV_HEADS, ATT_HEAD_DIM)
    qb = q.reshape(B, nb, ATT_BLOCK, ATT_KV_HEADS, G, ATT_HEAD_DIM)
    pad = ((0, 0), (ATT_BLOCK, 0), (0, 0), (0, 0))
    kp = jnp.pad(k, pad).reshape(B, nb + 1, ATT_BLOCK, ATT_KV_HEADS, ATT_HEAD_DIM)
    vp = jnp.pad(v, pad).reshape(B, nb + 1, ATT_BLOCK, ATT_KV_HEADS, ATT_HEAD_DIM)
    kb = jnp.concatenate([kp[:, :-1], kp[:, 1:]], axis=2)
    vb = jnp.concatenate([vp[:, :-1], vp[:, 1:]], axis=2)
    scores = jnp.einsum('bnqkgd,bnskd->bnkgqs', qb, kb).astype(jnp.float32) * (ATT_HEAD_DIM ** -0.5)
    qi = jnp.arange(ATT_BLOCK)[:, None]
    kj = jnp.arange(2 * ATT_BLOCK)[None, :]
    dist = qi + ATT_BLOCK - kj
    in_window = (dist >= 0) & (dist < WINDOW)
    key_pos = jnp.arange(nb)[:, None, None] * ATT_BLOCK + kj[None] - ATT_BLOCK
    valid = in_window[None] & (key_pos >= 0)
    bucket = t5_bucket(jnp.clip(dist, 0, WINDOW - 1))
    bias = rel_bias.astype(jnp.float32)[bucket]
    bias = bias.transpose(2, 0, 1).reshape(ATT_KV_HEADS, G, ATT_BLOCK, 2 * ATT_BLOCK)
    logits = jnp.where(valid[None, :, None, None], scores + bias, -jnp.inf)
    sink_l = sink.astype(jnp.float32).reshape(ATT_KV_HEADS, G)[:, :, None, None]
    m = jnp.maximum(jnp.max(logits, axis=-1, keepdims=True), sink_l)
    p = jnp.exp(logits - m)
    probs = p / (jnp.sum(p, axis=-1, keepdims=True) + jnp.exp(sink_l - m))
    out = jnp.einsum('bnkgqs,bnskd->bnqkgd', probs.astype(vb.dtype), vb)
    return out.reshape(B, S, ATT_WIDTH)


def causal_conv_silu(x, w, b):
    K = w.shape[0]
    S = x.shape[1]
    xp = jnp.pad(x, ((0, 0), (K - 1, 0), (0, 0)))
    y = xp[:, 0:S] * w[0]
    for j in range(1, K):
        y = y + xp[:, j:j + S] * w[j]
    return jax.nn.silu(y + b)


def mlstm_chunkwise(q, k, v, i_pre, f_pre):
    B, S = q.shape[0], q.shape[1]
    nc = S // ML_CHUNK

    def to_chunks(a):
        a = a.reshape(B, nc, ML_CHUNK, ML_HEADS, *a.shape[3:])
        return jnp.moveaxis(a, (1, 3), (0, 2))

    qc = to_chunks(q.astype(jnp.float32))
    kc = to_chunks(k.astype(jnp.float32) * (ML_DQK ** -0.5))
    vc = to_chunks(v.astype(jnp.float32))
    lic = to_chunks(i_pre.astype(jnp.float32))
    lfc = to_chunks(jax.nn.log_sigmoid(f_pre.astype(jnp.float32)))
    causal = jnp.tril(jnp.ones((ML_CHUNK, ML_CHUNK), dtype=bool))

    def step(carry, inp):
        C, n, m = carry
        qt, kt, vt, li, lf = inp
        b = jnp.cumsum(lf, axis=-1)
        log_d = jnp.where(causal, b[..., :, None] - b[..., None, :] + li[..., None, :], -jnp.inf)
        m_inter = b + m[..., None]
        m_row = jnp.maximum(m_inter, jnp.max(log_d, axis=-1))
        d = jnp.exp(log_d - m_row[..., None])
        inter_scale = jnp.exp(m_inter - m_row)
        s = jnp.einsum('bhtd,bhsd->bhts', qt, kt) * d
        num = inter_scale[..., None] * jnp.einsum('bhvd,bhtd->bhtv', C, qt) + jnp.einsum('bhts,bhsv->bhtv', s, vt)
        den = inter_scale * jnp.einsum('bhd,bhtd->bht', n, qt) + jnp.sum(s, axis=-1)
        h = num / jnp.maximum(jnp.abs(den), jnp.exp(-m_row))[..., None]
        b_last = b[..., -1]
        log_w = b_last[..., None] - b + li
        m_next = jnp.maximum(b_last + m, jnp.max(log_w, axis=-1))
        w = jnp.exp(log_w - m_next[..., None])
        decay = jnp.exp(b_last + m - m_next)
        C_next = decay[..., None, None] * C + jnp.einsum('bhs,bhsv,bhsd->bhvd', w, vt, kt)
        n_next = decay[..., None] * n + jnp.einsum('bhs,bhsd->bhd', w, kt)
        return (C_next, n_next, m_next), h

    init = (jnp.zeros((B, ML_HEADS, ML_DV, ML_DQK), jnp.float32),
            jnp.zeros((B, ML_HEADS, ML_DQK), jnp.float32),
            jnp.zeros((B, ML_HEADS), jnp.float32))
    _, h = lax.scan(step, init, (qc, kc, vc, lic, lfc))
    h = jnp.moveaxis(h, (0, 2), (1, 3))
    return h.reshape(B, S, ML_HEADS, ML_DV)


def hier_moe(x, w_rg, b_rg, w_re, b_re, w_gate, w_up, w_down):
    B, S, D = x.shape
    t = x.reshape(-1, D)
    g_logits = (t @ w_rg).astype(jnp.float32) + b_rg.astype(jnp.float32)
    g_prob = jax.nn.softmax(g_logits, axis=-1)
    grp = jnp.argmax(g_logits, axis=-1)
    p_grp = jnp.take_along_axis(g_prob, grp[:, None], axis=-1)
    e_logits = ((t @ w_re).astype(jnp.float32) + b_re.astype(jnp.float32)).reshape(-1, N_GROUPS, EXPERTS_PER_GROUP)
    e_in = jnp.take_along_axis(e_logits, grp[:, None, None], axis=1)[:, 0]
    e_prob = jax.nn.softmax(e_in, axis=-1)
    top_p, top_i = lax.top_k(e_prob, TOP_K)
    top_p = top_p / jnp.sum(top_p, axis=-1, keepdims=True)
    weights = p_grp * top_p
    expert_ids = grp[:, None] * EXPERTS_PER_GROUP + top_i
    combine = jnp.sum(jax.nn.one_hot(expert_ids, N_EXPERTS, dtype=jnp.float32) * weights[..., None], axis=1)
    y = jnp.zeros(t.shape, jnp.float32)
    for e in range(N_EXPERTS):
        h = jax.nn.silu(t @ w_gate[e]) * (t @ w_up[e])
        y = y + combine[:, e:e + 1] * (h @ w_down[e]).astype(jnp.float32)
    return y.astype(x.dtype).reshape(B, S, D)


def setup_inputs(seed: int = 0) -> dict:
    key = jax.random.key(seed)
    ks = jax.random.split(key, 20)
    f32 = jnp.float32
    nrm = lambda k, shape, s: jax.random.normal(k, shape, f32) * s
    gate_b = jnp.concatenate([
        nrm(ks[9], (DEPTH, ML_HEADS), 0.1),
        jnp.linspace(3.0, 6.0, ML_HEADS, dtype=f32)[None, :] + nrm(ks[10], (DEPTH, ML_HEADS), 0.1)], axis=-1)
    return {
        "x": nrm(ks[0], (BATCH, SEQ, D_MODEL), 1.0),
        "rel_bias": nrm(ks[1], (N_BUCKETS, ATT_HEADS), 0.5),
        "norm_mix_g": 1.0 + nrm(ks[2], (DEPTH, D_MODEL), 0.02),
        "w_in": nrm(ks[3], (DEPTH, D_MODEL, N_IN), D_MODEL ** -0.5),
        "q_norm_g": 1.0 + nrm(ks[4], (DEPTH, ATT_HEAD_DIM), 0.02),
        "k_norm_g": 1.0 + nrm(ks[5], (DEPTH, ATT_HEAD_DIM), 0.02),
        "attn_sink": nrm(ks[6], (DEPTH, ATT_HEADS), 0.5),
        "conv_w": nrm(ks[7], (DEPTH, CONV_K, 2 * ML_HEADS * ML_DQK), CONV_K ** -0.5),
        "conv_b": nrm(ks[8], (DEPTH, 2 * ML_HEADS * ML_DQK), 0.02),
        "gate_b": gate_b,
        "mlstm_norm_g": 1.0 + nrm(ks[11], (DEPTH, ML_WIDTH), 0.02),
        "w_out": nrm(ks[12], (DEPTH, D_MIX, D_MODEL), D_MIX ** -0.5),
        "norm_ffn_g": 1.0 + nrm(ks[13], (DEPTH, D_MODEL), 0.02),
        "w_router_group": nrm(ks[14], (DEPTH, D_MODEL, N_GROUPS), D_MODEL ** -0.5),
        "b_router_group": nrm(ks[15], (DEPTH, N_GROUPS), 0.01),
        "w_router_expert": nrm(ks[16], (DEPTH, D_MODEL, N_EXPERTS), D_MODEL ** -0.5),
        "b_router_expert": nrm(ks[17], (DEPTH, N_EXPERTS), 0.01),
        "w_gate": nrm(ks[18], (DEPTH, N_EXPERTS, D_MODEL, D_FF_EXPERT), D_MODEL ** -0.5),
        "w_up": nrm(jax.random.fold_in(ks[18], 1), (DEPTH, N_EXPERTS, D_MODEL, D_FF_EXPERT), D_MODEL ** -0.5),
        "w_down": nrm(ks[19], (DEPTH, N_EXPERTS, D_FF_EXPERT, D_MODEL), D_FF_EXPERT ** -0.5),
    }


def reference(x, rel_bias, norm_mix_g, w_in, q_norm_g, k_norm_g, attn_sink, conv_w, conv_b, gate_b,
              mlstm_norm_g, w_out, norm_ffn_g, w_router_group, b_router_group, w_router_expert,
              b_router_expert, w_gate, w_up, w_down):
    B, S, _ = x.shape
    for l in range(DEPTH):
        hn = rms_norm(x, norm_mix_g[l])
        proj = hn @ w_in[l]
        q_a, k_a, v_a, q_m, k_m, v_m, o_m, i_m, f_m = jnp.split(proj, SPLIT_POINTS, axis=-1)
        att = swa_sink_attention(q_a, k_a, v_a, q_norm_g[l], k_norm_g[l], attn_sink[l], rel_bias)
        qk_m = causal_conv_silu(jnp.concatenate([q_m, k_m], axis=-1), conv_w[l], conv_b[l])
        q_m, k_m = jnp.split(qk_m, 2, axis=-1)
        i_pre = i_m + gate_b[l, :ML_HEADS]
        f_pre = f_m + gate_b[l, ML_HEADS:]
        h_m = mlstm_chunkwise(q_m.reshape(B, S, ML_HEADS, ML_DQK), k_m.reshape(B, S, ML_HEADS, ML_DQK),
                              v_m.reshape(B, S, ML_HEADS, ML_DV), i_pre, f_pre).astype(x.dtype)
        h_m = rms_norm(h_m, mlstm_norm_g[l].reshape(ML_HEADS, ML_DV)).reshape(B, S, ML_WIDTH) * jax.nn.sigmoid(o_m)
        x = x + jnp.concatenate([att, h_m], axis=-1) @ w_out[l]
        x = x + hier_moe(rms_norm(x, norm_ffn_g[l]), w_router_group[l], b_router_group[l],
                         w_router_expert[l], b_router_expert[l], w_gate[l], w_up[l], w_down[l])
    return x
```

```cpp
#include <hip/hip_runtime.h>
#include <cstdio>
#include <cstdint>

typedef unsigned short bf16_t;
constexpr int T = 16384, SEQ = 4096, D = 1024, NIN = 2312, NPROJ = 2304;
constexpr size_t MiB = 1u << 20;

__device__ __forceinline__ float bf2f(bf16_t v) { return __uint_as_float((unsigned)v << 16); }
__device__ __forceinline__ bf16_t f2bf(float f) { unsigned u = __float_as_uint(f); return (bf16_t)((u + 0x7fffu + ((u >> 16) & 1u)) >> 16); }
__device__ __forceinline__ float wave_sum(float v) {
#pragma unroll
    for (int o = 1; o < 64; o <<= 1) v += __shfl_xor(v, o);
    return v;
}
__device__ __forceinline__ float wave_max(float v) {
#pragma unroll
    for (int o = 1; o < 64; o <<= 1) v = fmaxf(v, __shfl_xor(v, o));
    return v;
}
__device__ __forceinline__ float siluf(float x) { return x / (1.f + __expf(-x)); }
__device__ __forceinline__ float sigmoidf(float x) { return 1.f / (1.f + __expf(-x)); }

__device__ __forceinline__ int t5_bucket(int dist) {
    if (dist < 16) return dist;
    const float d = (float)dist;
    int large = 16 + (int)(logf(d / 16.f) / logf(8.f) * 16.f);
    return large < 31 ? large : 31;
}

namespace fk {
#define LAS __attribute__((address_space(3)))
typedef short bf16x8 __attribute__((ext_vector_type(8)));
typedef float f32x4 __attribute__((ext_vector_type(4)));
typedef float f32x2 __attribute__((ext_vector_type(2)));
typedef unsigned u32x4 __attribute__((ext_vector_type(4)));
typedef unsigned u32x2 __attribute__((ext_vector_type(2)));
constexpr int NWAVES = 8, NTHR = 512;
constexpr int BM = 256, BK = 64, HALF = 128, HTB = HALF * BK * 2, STAGE_BYTES = 8 * HTB;
constexpr int LDS_BYTES = 147456;
constexpr int MISC_OFF = STAGE_BYTES;
constexpr size_t FW_CTL = 0;
constexpr size_t FW_WIN = 1 * MiB;
constexpr size_t FW_WOUT = 11 * MiB;
constexpr size_t FW_WGU = 15 * MiB;
constexpr size_t FW_WD = 79 * MiB;
constexpr size_t FW_XG = 111 * MiB;
constexpr size_t FW_PROJ = 143 * MiB;
constexpr size_t FW_MIX = 215 * MiB;
constexpr size_t FW_SSQ = 247 * MiB;
constexpr size_t FW_GATES = 248 * MiB;
constexpr size_t FW_RB = 249 * MiB;
constexpr size_t FW_RW = FW_RB + 65536;
constexpr size_t FW_LPOS = FW_RW + 262144;
constexpr size_t FW_CNT = FW_LPOS + 65536;
constexpr size_t FW_ROWTOK = FW_CNT + 32768;
constexpr size_t FW_ROWW = FW_ROWTOK + 131072;
constexpr size_t FW_TILEB = FW_ROWW + 524288;
constexpr size_t FW_NIN = FW_TILEB + 4096;
constexpr size_t FW_NST = FW_NIN + 262144;
constexpr size_t FW_SC = FW_NST + 262144;
constexpr size_t FW_MST = FW_SC + 8192;
constexpr size_t FW_RT = FW_MST + 4096;
constexpr size_t OUT_USTATE = 0;
constexpr size_t OUT_CSTATE = 16 * MiB;
constexpr size_t FW_ROWTOKB = 252 * MiB;
constexpr int CW_CONVQ = 512, CW_BAR = 4096, CW_BCNT = 8192, CW_UPCNT = 8704;
constexpr int MAXROWS = 16384 + 24 * 256;
constexpr int WIN_ROWS = 2560;

__device__ __forceinline__ unsigned pk2(float lo, float hi) { return (unsigned)f2bf(lo) | ((unsigned)f2bf(hi) << 16); }
typedef __bf16 bf16x2_t __attribute__((ext_vector_type(2)));
__device__ __forceinline__ unsigned cvt_pk_op(float lo, float hi);
__device__ __forceinline__ unsigned cvt_pk_bf16(float lo, float hi) { return cvt_pk_op(lo, hi); }
__device__ __forceinline__ unsigned cvt_pk_op(float lo, float hi) { const f32x2 v = {lo, hi}; const bf16x2_t b = __builtin_convertvector(v, bf16x2_t); return __builtin_bit_cast(unsigned, b); }

__device__ __forceinline__ void unpack8(const u32x4 r, float (&f)[8]) {
    f[0] = __uint_as_float(r.x << 16); f[1] = __uint_as_float(r.x & 0xffff0000u); f[2] = __uint_as_float(r.y << 16); f[3] = __uint_as_float(r.y & 0xffff0000u);
    f[4] = __uint_as_float(r.z << 16); f[5] = __uint_as_float(r.z & 0xffff0000u); f[6] = __uint_as_float(r.w << 16); f[7] = __uint_as_float(r.w & 0xffff0000u);
}
__device__ __forceinline__ bf16x8 pack8(const float (&f)[8]) {
    u32x4 w; w.x = cvt_pk_op(f[0], f[1]); w.y = cvt_pk_op(f[2], f[3]); w.z = cvt_pk_op(f[4], f[5]); w.w = cvt_pk_op(f[6], f[7]);
    return __builtin_bit_cast(bf16x8, w);
}

__device__ __forceinline__ int lds_byte(int r, int c) { const int st = (r >> 4) * 2 + (c >> 5), rr = r & 15, cc = c & 31, ob = rr * 64 + cc * 2; return st * 1024 + (ob ^ (((ob >> 9) & 1) << 5)); }
__device__ __forceinline__ void stage_rc(int b, int& R, int& C) { const int st = b / 1024, sb = b % 1024, swz = sb ^ (((sb >> 9) & 1) << 5); R = (st >> 1) * 16 + swz / 64; C = (st & 1) * 32 + (swz % 64) / 2; }
__device__ __forceinline__ int perm32(int rho) { const int n = rho >> 4, i = rho & 15; return 8 * (i >> 2) + 4 * n + (i & 3); }

__device__ __forceinline__ int tid_of(int swave) { int l; asm volatile("v_mbcnt_lo_u32_b32 %0, -1, 0\n\tv_mbcnt_hi_u32_b32 %0, -1, %0" : "=v"(l)); return swave * 64 + l; }
struct Unit { const char* A; const char* B0; const char* B1; const int* rows; const int* rtok; int pm, pn, aux, nvalid, half; };

struct Args {
    const float* in[20]; float* out; unsigned char* ws; int ph_lo, ph_hi;
};
enum { I_X = 0, I_RELB, I_NMIXG, I_WIN, I_QG, I_KG, I_SINK, I_CONVW, I_CONVB, I_GATEB, I_MNORMG, I_WOUT, I_NFFNG, I_WRG, I_BRG, I_WRE, I_BRE, I_WGATE, I_WUP, I_WDOWN };


template <class Epi, class Sched, bool MOE>
__device__ __forceinline__ void gemm_phase(LAS unsigned char* lds, const int lda, const int ldb, const int nt, const Sched& S, const Epi& E, const int swave) {
    int tid = tid_of(swave); asm volatile("" : "+v"(tid));
    const int wid = __builtin_amdgcn_readfirstlane(tid >> 6), lane = tid & 63, wr = wid >> 2, wc = wid & 3, fr = lane & 15, fq = lane >> 4;
    int Rr[2], Cc[2]; unsigned voffB[2], voffBd[2];
#pragma unroll
    for (int i = 0; i < 2; ++i) { int R, C; stage_rc(tid * 16 + i * 8192, R, C); Rr[i] = R; Cc[i] = C; const int Rb = (R & ~31) + perm32(R & 31); voffB[i] = (unsigned)(Rb * ldb + C) * 2u; voffBd[i] = (unsigned)(Rb * 512 + C) * 2u; }
    const size_t kstep = (size_t)(BK * 2);
    const size_t hstepB = (size_t)HALF * ldb * 2, hstepBd = (size_t)HALF * 512 * 2;
    const unsigned ldsw = (unsigned)wid * 1024u;
    const int aoff = lds_byte(wr * 64 + fr, fq * 8), boff = lds_byte(wc * 32 + fr, fq * 8);
#define FK_SA(b, h) (((b) * 2 + (h)) * HTB)
#define FK_SB(b, h) ((4 + (b) * 2 + (h)) * HTB)
#define FK_STAGE(bufoff, gbase, voff) do { _Pragma("unroll") for (int _i = 0; _i < 2; ++_i) \
        __builtin_amdgcn_global_load_lds((const unsigned*)((const char*)(gbase) + (voff)[_i]), (LAS unsigned*)(lds + (bufoff) + ldsw + _i * 8192), 16, 0, 0); } while (0)
#define FK_LDA(dst, b, h) do { _Pragma("unroll") for (int m = 0; m < 4; ++m) _Pragma("unroll") for (int k = 0; k < 2; ++k) dst[m][k] = *(const LAS bf16x8*)(lds + FK_SA(b, h) + aoff + m * 2048 + k * 1024); } while (0)
#define FK_LDB(dst, b, h) do { _Pragma("unroll") for (int n = 0; n < 2; ++n) _Pragma("unroll") for (int k = 0; k < 2; ++k) dst[n][k] = *(const LAS bf16x8*)(lds + FK_SB(b, h) + boff + n * 2048 + k * 1024); } while (0)
#define FK_MMA(ai, bj, At, Bt) do { __builtin_amdgcn_s_setprio(1); _Pragma("unroll") for (int m = 0; m < 4; ++m) _Pragma("unroll") for (int n = 0; n < 2; ++n) _Pragma("unroll") for (int k = 0; k < 2; ++k) \
        acc[ai][bj][m][n] = __builtin_amdgcn_mfma_f32_16x16x32_bf16(Bt[n][k], At[m][k], acc[ai][bj][m][n], 0, 0, 0); __builtin_amdgcn_s_setprio(0); } while (0)
#define FK_WAIT_V(n) asm volatile("s_waitcnt vmcnt(" #n ")" ::: "memory")
#define FK_WAIT_L(n) asm volatile("s_waitcnt lgkmcnt(" #n ")" ::: "memory")
#define FK_BAR __builtin_amdgcn_s_barrier()
#define FK_SCHED __builtin_amdgcn_sched_barrier(0)
#define FK_VOFF(u, v) do { _Pragma("unroll") for (int _h = 0; _h < 2; ++_h) _Pragma("unroll") for (int _i = 0; _i < 2; ++_i) { \
        const int _rr = _h * HALF + Rr[_i]; int _row = _rr; \
        if constexpr (MOE) { if ((u).rows) { const int _rc = _rr < (u).nvalid ? _rr : (u).nvalid - 1; _row = __builtin_nontemporal_load((u).rows + _rc); } }     \
        v[_h][_i] = (unsigned)(_row * lda + Cc[_i]) * 2u; \
        asm volatile("" : "+v"(v[_h][_i])); } } while (0)
    Unit cur, nxt; int ui = 0; int pend = -1;
    if (!S.next(0, cur)) return;
    f32x4 acc[2][2][4][2];
#pragma unroll
    for (int a = 0; a < 2; ++a)
#pragma unroll
        for (int b = 0; b < 2; ++b)
#pragma unroll
            for (int m = 0; m < 4; ++m)
#pragma unroll
                for (int n = 0; n < 2; ++n) acc[a][b][m][n] = (f32x4){0.f, 0.f, 0.f, 0.f};
    bf16x8 At[4][2], B0[2][2], B1[2][2];
    unsigned vC[2][2], vN[2][2], vbC[2], vbN[2]; int rawN[2][2];
    size_t hsC = hstepB, hsN = hstepB;
#pragma unroll
    for (int i = 0; i < 2; ++i) { vbC[i] = voffB[i]; vbN[i] = voffB[i]; }
    if constexpr (MOE) { if (cur.aux) { vbC[0] = voffBd[0]; vbC[1] = voffBd[1]; hsC = hstepBd; } }
    FK_VOFF(cur, vC);
    const char* cA = cur.A;
    LAS float* misc = (LAS float*)(lds + MISC_OFF);
    E.prep_all(S, misc, tid);
    S.a_ready(cur, wid, lane);
    FK_STAGE(FK_SB(0, 0), cur.B0, vbC); FK_STAGE(FK_SB(0, 1), cur.B0 + hsC, vbC); FK_STAGE(FK_SA(0, 0), cA, vC[0]); FK_STAGE(FK_SA(0, 1), cA, vC[1]);
    if (wr == 1) FK_BAR;
    FK_WAIT_V(2); FK_BAR;
    FK_STAGE(FK_SB(1, 0), cur.B0 + kstep, vbC); FK_STAGE(FK_SA(1, 0), cA + kstep, vC[0]); FK_STAGE(FK_SB(1, 1), cur.B0 + hsC + kstep, vbC);
    FK_WAIT_V(6); FK_BAR;
    for (;;) {
        const bool has_next = S.next(ui + 1, nxt);
        if constexpr (MOE) {
            if (has_next) {
#pragma unroll
                for (int h = 0; h < 2; ++h)
#pragma unroll
                    for (int i = 0; i < 2; ++i) { const int rr = h * HALF + Rr[i]; int row = rr;
                        if (nxt.rows) { const int rc = rr < nxt.nvalid ? rr : nxt.nvalid - 1; row = __builtin_nontemporal_load(nxt.rows + rc); }
                        rawN[h][i] = row; }
                const bool dn = nxt.aux != 0; vbN[0] = dn ? voffBd[0] : voffB[0]; vbN[1] = dn ? voffBd[1] : voffB[1]; hsN = dn ? hstepBd : hstepB;
            } else {
#pragma unroll
                for (int h = 0; h < 2; ++h)
#pragma unroll
                    for (int i = 0; i < 2; ++i) rawN[h][i] = -1;
                vbN[0] = vbC[0]; vbN[1] = vbC[1]; hsN = hsC;
            }
        }
        const char* nA = has_next ? nxt.A : cA; const char* nB = has_next ? nxt.B0 : cur.B0;
        const bool do0 = cur.half != 1, do1 = cur.half != 0;
        for (int t = 0; t < nt; t += 2) {
            const bool last = (t == nt - 2);
            const char* a1 = cA + (size_t)(t + 1) * kstep;
            const char* a2 = last ? nA : cA + (size_t)(t + 2) * kstep;
            const char* bseg = (t + 2 < (nt >> 1)) ? cur.B0 : cur.B1;
            const char* b2 = last ? nB : bseg + (size_t)(t + 2) * kstep;
            const char* a3 = a2 + kstep; const char* b3 = b2 + kstep;
            if (last && has_next) S.a_ready(nxt, wid, lane);
            if constexpr (MOE) { if (last) {
#pragma unroll
                for (int h = 0; h < 2; ++h)
#pragma unroll
                    for (int i = 0; i < 2; ++i) vN[h][i] = rawN[h][i] < 0 ? vC[h][i] : (unsigned)(rawN[h][i] * lda + Cc[i]) * 2u;
            } }
            unsigned va2[2][2], vb2[2]; size_t hs2 = hsC;
#pragma unroll
            for (int h = 0; h < 2; ++h)
#pragma unroll
                for (int i = 0; i < 2; ++i) { if constexpr (MOE) va2[h][i] = last ? vN[h][i] : vC[h][i]; else va2[h][i] = vC[h][i]; }
#pragma unroll
            for (int i = 0; i < 2; ++i) { if constexpr (MOE) vb2[i] = last ? vbN[i] : vbC[i]; else vb2[i] = vbC[i]; }
            if constexpr (MOE) hs2 = last ? hsN : hsC;
            FK_LDB(B0, 0, 0); FK_LDB(B1, 0, 1); FK_SCHED; FK_LDA(At, 0, 0); FK_STAGE(FK_SA(1, 1), a1, vC[1]);
            FK_WAIT_V(8); FK_WAIT_L(0); FK_BAR; if (do0) { FK_MMA(0, 0, At, B0); FK_MMA(0, 1, At, B1); } FK_BAR; FK_SCHED;
            FK_LDA(At, 0, 1); FK_STAGE(FK_SB(0, 0), b2, vb2); FK_STAGE(FK_SB(0, 1), b2 + hs2, vb2); FK_STAGE(FK_SA(0, 0), a2, va2[0]);
            FK_WAIT_V(8);
            if constexpr (MOE) { if (pend >= 0) { E.publish(pend, lane); pend = -1; } }
            FK_WAIT_L(0); FK_BAR; if (do1) { FK_MMA(1, 0, At, B0); FK_MMA(1, 1, At, B1); } FK_BAR; FK_SCHED;
            FK_LDB(B0, 1, 0); FK_LDB(B1, 1, 1); FK_SCHED; FK_LDA(At, 1, 0); FK_STAGE(FK_SA(0, 1), a2, va2[1]);
            FK_WAIT_V(8); FK_WAIT_L(0); FK_BAR; if (do0) { FK_MMA(0, 0, At, B0); FK_MMA(0, 1, At, B1); } FK_BAR; FK_SCHED;
            FK_LDA(At, 1, 1); FK_STAGE(FK_SB(1, 0), b3, vb2); FK_STAGE(FK_SB(1, 1), b3 + hs2, vb2); FK_STAGE(FK_SA(1, 0), a3, va2[0]);
            FK_WAIT_V(8); FK_WAIT_L(0); FK_BAR; if (do1) { FK_MMA(1, 0, At, B0); FK_MMA(1, 1, At, B1); } FK_BAR; FK_SCHED;
        }
        if (wr == 0) FK_BAR;
        { int fr_ = fr, fq_ = fq; asm volatile("" : "+v"(fr_), "+v"(fq_)); if constexpr (MOE) pend = E(acc, cur, ui, misc, wr, wc, fr_, fq_); else E(acc, cur, ui, misc, wr, wc, fr_, fq_); }
        if (!has_next) break;
#pragma unroll
        for (int a = 0; a < 2; ++a)
#pragma unroll
            for (int b = 0; b < 2; ++b)
#pragma unroll
                for (int m = 0; m < 4; ++m)
#pragma unroll
                    for (int n = 0; n < 2; ++n) acc[a][b][m][n] = (f32x4){0.f, 0.f, 0.f, 0.f};
        cur = nxt; cA = nA; ++ui;
        if constexpr (MOE) {
#pragma unroll
            for (int h = 0; h < 2; ++h)
#pragma unroll
                for (int i = 0; i < 2; ++i) vC[h][i] = vN[h][i];
            vbC[0] = vbN[0]; vbC[1] = vbN[1]; hsC = hsN;
        }
        if (wr == 1) FK_BAR;
    }
    FK_WAIT_V(0);
    if constexpr (MOE) { if (pend >= 0) E.publish(pend, lane); }
    FK_BAR;
#undef FK_SA
#undef FK_SB
#undef FK_STAGE
#undef FK_LDA
#undef FK_LDB
#undef FK_MMA
#undef FK_WAIT_V
#undef FK_WAIT_L
#undef FK_BAR
#undef FK_SCHED
#undef FK_VOFF
}

__device__ __forceinline__ bool deal_item(int i, int n, int G, int c, bool split, int& L, int& half) {
    const int rounds = n / G, tail = n - rounds * G;
    half = -1;
    if (i < rounds) { L = i * G + c; return true; }
    if (i > rounds || tail == 0) return false;
    if (split && 2 * tail <= G) { if (c >= 2 * tail) return false; L = rounds * G + (c >> 1); half = c & 1; return true; }
    if (c >= tail) return false;
    L = rounds * G + c; return true;
}
struct DenseOrder {
    int nM, nN, nwg, G, c; const char* A; const char* Bt; size_t tstepA, tstepB;
    __device__ void init(int M, int N, int G_, int c_, const void* A_, int lda, const void* Bt_, int ldb) { nM = M / BM; nN = N / BM; nwg = nM * nN; G = G_; c = c_; A = (const char*)A_; Bt = (const char*)Bt_; tstepA = (size_t)BM * lda * 2; tstepB = (size_t)BM * ldb * 2; }
    __device__ __forceinline__ bool next(int i, Unit& u) const {
        int L, half; if (!deal_item(i, nwg, G, c, false, L, half)) return false;
        int wgid = L; { const int q = nwg / 8, r = nwg % 8, xcd = wgid % 8, off = wgid / 8; wgid = (xcd < r ? xcd * (q + 1) : r * (q + 1) + (xcd - r) * q) + off; }
        const int nig = 8 * nN, gid = wgid / nig, fm = gid * 8, gsz = (nM - fm) < 8 ? (nM - fm) : 8;
        u.pm = fm + ((wgid % nig) % gsz); u.pn = (wgid % nig) / gsz;
        u.A = A + (size_t)u.pm * tstepA; u.B0 = Bt + (size_t)u.pn * tstepB; u.B1 = u.B0; u.rows = nullptr; u.rtok = nullptr; u.aux = 0; u.nvalid = BM; u.half = half; return true;
    }
    __device__ __forceinline__ void a_ready(const Unit&, int, int) const {}
};

struct EpiInProj {
    const float* ssq; bf16_t* proj; float* gates; const float* gate_b;
    template <class Sched> __device__ __forceinline__ void prep_all(const Sched& S, LAS float* misc, int tid) const {
        const int r = tid >> 1; f32x4 s0[4], s1[4]; bool have[4];
#pragma unroll
        for (int i = 0; i < 4; ++i) { Unit u; have[i] = S.next(i, u); const int pm = have[i] ? u.pm : 0;
            const f32x4* sp = (const f32x4*)(ssq + (size_t)(pm * BM + r) * 16 + (tid & 1) * 8); s0[i] = sp[0]; s1[i] = sp[1]; }
#pragma unroll
        for (int i = 0; i < 4; ++i) {
            float ss = ((s0[i][0] + s0[i][1]) + (s0[i][2] + s0[i][3])) + ((s1[i][0] + s1[i][1]) + (s1[i][2] + s1[i][3]));
            ss += __shfl_xor(ss, 1);
            if (have[i] && (tid & 1) == 0) misc[i * 256 + r] = rsqrtf(ss * (1.f / 1024.f) + 1e-6f);
        }
    }
    __device__ __forceinline__ void prep(const Unit&, int, LAS float*, int) const {}
    __device__ __forceinline__ void operator()(const f32x4 (&acc)[2][2][4][2], const Unit& u, int ui, const LAS float* misc, int wr, int wc, int fr, int fq) const {
        const int rl0 = wr * 64 + fr, row0 = u.pm * BM + rl0;
        const LAS float* tab = misc + ui * 256;
#pragma unroll
        for (int ai = 0; ai < 2; ++ai)
#pragma unroll
            for (int m = 0; m < 4; ++m) {
                if (u.half >= 0 && u.half != ai) continue;
                const int row = row0 + ai * HALF + m * 16;
                const float rs = tab[rl0 + ai * HALF + m * 16];
                if (u.pn < 9) {
                    bf16_t* rowp = proj + (size_t)row * NPROJ + u.pn * BM + wc * 32 + 8 * fq;
#pragma unroll
                    for (int bj = 0; bj < 2; ++bj) { const f32x4 v0 = acc[ai][bj][m][0] * rs, v1 = acc[ai][bj][m][1] * rs;
                        u32x4 w; w.x = cvt_pk_bf16(v0[0], v0[1]); w.y = cvt_pk_bf16(v0[2], v0[3]); w.z = cvt_pk_bf16(v1[0], v1[1]); w.w = cvt_pk_bf16(v1[2], v1[3]);
                        *(u32x4*)(rowp + bj * HALF) = w; }
                } else if (wc == 0 && fq == 0) {
                    const f32x4 g0 = *(const f32x4*)(gate_b), g1 = *(const f32x4*)(gate_b + 4);
                    *(f32x4*)(gates + (size_t)row * 8) = acc[ai][0][m][0] * rs + g0;
                    *(f32x4*)(gates + (size_t)row * 8 + 4) = acc[ai][0][m][1] * rs + g1;
                }
            }
    }
};


template <bool INDIRECT, bool FINAL>
struct EpiResid {
    bf16_t* xb; float* out; float* ssq;
    template <class Sched> __device__ __forceinline__ void prep_all(const Sched&, LAS float*, int) const {}
    __device__ __forceinline__ void prep(const Unit&, int, LAS float*, int) const {}
    __device__ __forceinline__ void operator()(const f32x4 (&acc)[2][2][4][2], const Unit& u, int ui, const LAS float* misc, int wr, int wc, int fr, int fq) const {
        const int col0 = u.pn * BM + wc * 32 + 8 * fq;
        int tok[2][4];
#pragma unroll
        for (int ai = 0; ai < 2; ++ai)
#pragma unroll
            for (int m = 0; m < 4; ++m) { const int rl = ai * HALF + wr * 64 + m * 16 + fr; if constexpr (INDIRECT) { const int t_ = __builtin_nontemporal_load(u.rtok + (rl < u.nvalid ? rl : u.nvalid - 1)); tok[ai][m] = rl < u.nvalid ? t_ : -1; } else tok[ai][m] = u.pm * BM + rl; }
#pragma unroll
        for (int ai = 0; ai < 2; ++ai) {
            if (u.half >= 0 && u.half != ai) continue;
            u32x4 xr[4][2];
#pragma unroll
            for (int m = 0; m < 4; ++m)
#pragma unroll
                for (int bj = 0; bj < 2; ++bj) { const int tk = tok[ai][m] < 0 ? 0 : tok[ai][m]; xr[m][bj] = *(const u32x4*)(xb + (size_t)tk * D + col0 + bj * HALF); }
#pragma unroll
            for (int m = 0; m < 4; ++m) {
                const int tk = tok[ai][m];
                if (tk >= 0) {
                    const size_t off = (size_t)tk * D + col0;
                    float part = 0.f;
#pragma unroll
                    for (int bj = 0; bj < 2; ++bj) {
                        float x[8]; unpack8(xr[m][bj], x);
                        float h[8];
#pragma unroll
                        for (int j = 0; j < 4; ++j) { h[j] = x[j] + acc[ai][bj][m][0][j]; h[4 + j] = x[4 + j] + acc[ai][bj][m][1][j]; }
#pragma unroll
                        for (int j = 0; j < 8; ++j) part += h[j] * h[j];
                        if constexpr (FINAL) { *(f32x4*)(out + off + bj * HALF) = (f32x4){h[0], h[1], h[2], h[3]}; *(f32x4*)(out + off + bj * HALF + 4) = (f32x4){h[4], h[5], h[6], h[7]}; }
                        else { u32x4 w; w.x = cvt_pk_bf16(h[0], h[1]); w.y = cvt_pk_bf16(h[2], h[3]); w.z = cvt_pk_bf16(h[4], h[5]); w.w = cvt_pk_bf16(h[6], h[7]); *(u32x4*)(xb + off + bj * HALF) = w; }
                    }
                    if constexpr (!FINAL) {
                        part += __shfl_xor(part, 16); part += __shfl_xor(part, 32);
                        if (fq == 0) ssq[(size_t)tk * 16 + u.pn * 4 + wc] = part;
                    }
                }
            }
        }
    }
};

__device__ __forceinline__ void store16_sc1(void* p, u32x4 v) { asm volatile("global_store_dwordx4 %0, %1, off sc1\n\ts_nop 1" :: "v"(p), "v"(v) : "memory"); }
struct EpiUp {
    bf16_t* act; const float* rw; unsigned* upcnt;
    __device__ __forceinline__ void operator()(const f32x4 (&acc)[2][2][4][2], const Unit& u, int wr, int wc, int fr, int fq) const {
        const int slot = u.pn >> 2, col0 = slot * 512 + (u.pn & 3) * 128 + wc * 32 + 8 * fq;
        int tok[2][4];
#pragma unroll
        for (int ai = 0; ai < 2; ++ai)
#pragma unroll
            for (int m = 0; m < 4; ++m) { const int rl = ai * HALF + wr * 64 + m * 16 + fr; const int t_ = __builtin_nontemporal_load(u.rtok + (rl < u.nvalid ? rl : u.nvalid - 1)); tok[ai][m] = rl < u.nvalid ? t_ : -1; }
        f32x4 wv[2][4];
#pragma unroll
        for (int ai = 0; ai < 2; ++ai)
#pragma unroll
            for (int m = 0; m < 4; ++m) { const f32x4 w_ = __builtin_nontemporal_load((const f32x4*)(rw + (size_t)(tok[ai][m] < 0 ? 0 : tok[ai][m]) * 4)); wv[ai][m] = tok[ai][m] >= 0 ? w_ : (f32x4){0.f, 0.f, 0.f, 0.f}; }
#pragma unroll
        for (int ai = 0; ai < 2; ++ai)
#pragma unroll
            for (int m = 0; m < 4; ++m) {
                if (u.half >= 0 && u.half != ai) continue;
                const int rl = ai * HALF + wr * 64 + m * 16 + fr;
                const float rs = wv[ai][m][2], ws_ = (slot ? wv[ai][m][1] : wv[ai][m][0]) * rs;
                float o[8];
#pragma unroll
                for (int n = 0; n < 2; ++n)
#pragma unroll
                    for (int j = 0; j < 4; ++j) { const float gv = acc[ai][0][m][n][j] * rs, uv = acc[ai][1][m][n][j]; o[n * 4 + j] = gv * __builtin_amdgcn_rcpf(1.f + __expf(-gv)) * uv * ws_; }
                u32x4 pk; pk.x = cvt_pk_bf16(o[0], o[1]); pk.y = cvt_pk_bf16(o[2], o[3]); pk.z = cvt_pk_bf16(o[4], o[5]); pk.w = cvt_pk_bf16(o[6], o[7]);
                store16_sc1(act + ((size_t)u.pm * BM + rl) * 1024 + col0, pk);
            }
    }
    __device__ __forceinline__ void publish(int pend, int lane) const { if (lane == 0) __hip_atomic_fetch_add(upcnt + (pend >> 2), (unsigned)(pend & 3), __ATOMIC_RELAXED, __HIP_MEMORY_SCOPE_AGENT); }
};
template <bool FINAL>
struct EpiMoe {
    EpiUp up; EpiResid<true, FINAL> dn;
    template <class Sched> __device__ __forceinline__ void prep_all(const Sched&, LAS float*, int) const {}
    __device__ __forceinline__ void prep(const Unit&, int, LAS float*, int) const {}
    __device__ __forceinline__ int operator()(const f32x4 (&acc)[2][2][4][2], const Unit& u, int ui, const LAS float* misc, int wr, int wc, int fr, int fq) const {
        if (u.aux == 0) { up(acc, u, wr, wc, fr, fq); return u.pm * 4 + (u.half < 0 ? 2 : 1); }
        dn(acc, u, ui, misc, wr, wc, fr, fq); return -1;
    }
    __device__ __forceinline__ void publish(int tile, int lane) const { up.publish(tile, lane); }
};

__device__ __forceinline__ int ld_ctl(const int* p) { return (int)__hip_atomic_load((const unsigned*)p, __ATOMIC_RELAXED, __HIP_MEMORY_SCOPE_AGENT); }
__device__ __forceinline__ void pair_dec(int p, int& lo, int& hi) { lo = (p < 3) ? 0 : ((p < 5) ? 1 : 2); hi = (p < 3) ? p + 1 : ((p < 5) ? p - 1 : 3); }

struct MoeOrder {
    int ntile, G, c, nup8, ndn4;
    int pad_;
    const LAS int* tb; const int* rowtokb; const char* xb; const char* wgu; const char* act; const char* wd; unsigned* upcnt;
    __device__ __forceinline__ bool next(int i, Unit& u) const {
        int L, half = -1; const int kind = nup8 ? 0 : 1;
        if (kind == 0) { if (!deal_item(i, nup8 * 8, G, c, pad_ != 0, L, half)) return false; }
        else {
            const int nd = ndn4 * 4, rup = (ntile * 8) % G, nlight = G - rup; const bool heavy = c < rup;
            int tl = 0, th = 3, base = 0, mine = 0; L = -1;
            for (int r = 0; r < 1024 && base < nd; ++r) {
                const bool toheavy = (rup > 0) && (th + 2 < tl + 2);
                const int gsz = toheavy ? rup : nlight, gidx = toheavy ? c : c - rup;
                if (toheavy == heavy) { if (mine == i) { L = base + gidx; break; } ++mine; }
                if (toheavy) th += 2; else tl += 2;
                base += gsz;
            }
            if (L < 0 || L >= nd) return false;
        }
        const int mt = kind ? (L >> 2) : (L >> 3), pn = kind ? (L & 3) : (L & 7);
        int b = 0;
        for (int j = 1; j < 24; ++j) if (__builtin_amdgcn_readfirstlane(tb[j]) <= mt) b = j;
        const int jl = mt - __builtin_amdgcn_readfirstlane(tb[b]); const int left = __builtin_amdgcn_readfirstlane(tb[32 + b]) - jl * 256;
        const int grp = b / 6; int lo, hi; pair_dec(b % 6, lo, hi);
        u.pm = mt; u.pn = pn; u.aux = kind; u.nvalid = left < 256 ? left : 256; u.half = half;
        u.rtok = rowtokb + (size_t)b * T + jl * 256;
        if (kind == 0) { const int e = grp * 4 + ((pn >> 2) ? hi : lo);
            u.A = xb; u.rows = u.rtok; u.B0 = wgu + ((size_t)e * 1024 + (pn & 3) * 256) * 2048; u.B1 = u.B0; }
        else { u.A = act + (size_t)mt * BM * 2048; u.rows = nullptr;
            u.B0 = wd + ((size_t)(grp * 4 + lo) * 1024 + pn * 256) * 1024; u.B1 = wd + ((size_t)(grp * 4 + hi) * 1024 + pn * 256) * 1024 - 8 * 128; }
        return true;
    }
    __device__ __forceinline__ void a_ready(const Unit& u, int wid, int lane) const {
        if (u.aux != 0) {
            if (wid == 0) {
                unsigned spins = 0;
                while ((unsigned)__builtin_amdgcn_readfirstlane(__hip_atomic_load(upcnt + u.pm, __ATOMIC_RELAXED, __HIP_MEMORY_SCOPE_AGENT)) < 128u) { __builtin_amdgcn_s_sleep(2); if (++spins > (1u << 22)) break; }
                __builtin_amdgcn_fence(__ATOMIC_ACQUIRE, "agent");
                asm volatile("s_waitcnt vmcnt(0)" ::: "memory");
            }
            asm volatile("" ::: "memory"); __builtin_amdgcn_s_barrier(); asm volatile("" ::: "memory");
        }
    }
};

constexpr int RT_PITCH = 2064;
__device__ __forceinline__ void route1_phase(const Args& a, int l, LAS unsigned char* lds, int bx, int G, int tid) {
    unsigned char* ws = a.ws;
    const int wave = tid >> 6, lane = tid & 63;
    LAS unsigned char* Wt = lds; LAS float* red = (LAS float*)(lds + 48 * RT_PITCH);
    { const u32x4* rt = (const u32x4*)(ws + FW_RT + (size_t)l * 48 * 2048);
      for (int idx = tid; idx < 48 * 128; idx += NTHR) { const int r = idx >> 7, c16 = idx & 127; *(LAS u32x4*)(Wt + r * RT_PITCH + c16 * 16) = __builtin_nontemporal_load(rt + idx); } }
    __syncthreads();
    const bf16_t* hg = (const bf16_t*)(ws + FW_XG); const float* ssq = (const float*)(ws + FW_SSQ);
    float* RW = (float*)(ws + FW_RW); int* ROWTOKB = (int*)(ws + FW_ROWTOKB); unsigned* BCNT = (unsigned*)(ws + FW_CTL) + CW_BCNT + 64 * l;
    for (int slab = bx; slab < 256; slab += G) {
        const int mb = wave & 3, kh = wave >> 2, fr = lane & 15, fq = lane >> 4;
        f32x4 acc[3];
#pragma unroll
        for (int nb = 0; nb < 3; ++nb) acc[nb] = (f32x4){0.f, 0.f, 0.f, 0.f};
        const bf16_t* arow = hg + (size_t)(slab * 64 + mb * 16 + fr) * D + kh * 512 + fq * 8;
        bf16x8 afr[16];
#pragma unroll
        for (int ks = 0; ks < 16; ++ks) afr[ks] = *(const bf16x8*)(arow + ks * 32);
#pragma unroll
        for (int ks = 0; ks < 16; ++ks) {
            const bf16x8 af = afr[ks];
#pragma unroll
            for (int nb = 0; nb < 3; ++nb) {
                const bf16x8 bf = *(const LAS bf16x8*)(Wt + (nb * 16 + fr) * RT_PITCH + (kh * 512 + ks * 32 + fq * 8) * 2);
                acc[nb] = __builtin_amdgcn_mfma_f32_16x16x32_bf16(af, bf, acc[nb], 0, 0, 0);
            }
        }
#pragma unroll
        for (int nb = 0; nb < 3; ++nb)
#pragma unroll
            for (int r = 0; r < 4; ++r) red[(kh * 64 + mb * 16 + fq * 4 + r) * 48 + nb * 16 + fr] = acc[nb][r];
        __syncthreads();
        if (tid < 64) {
            const int t = slab * 64 + tid;
            float lg[20];
#pragma unroll
            for (int j = 0; j < 20; ++j) lg[j] = (red[tid * 48 + j] + red[(64 + tid) * 48 + j]) + (red[tid * 48 + 24 + j] + red[(64 + tid) * 48 + 24 + j]);
            float ss = 0.f;
#pragma unroll
            for (int i = 0; i < 16; ++i) ss += ssq[(size_t)t * 16 + i];
            const float rs = rsqrtf(ss * (1.f / 1024.f) + 1e-6f);
            const float* brg = a.in[I_BRG] + l * 4; const float* bre = a.in[I_BRE] + l * 16;
            float gl[4]; int grp = 0;
#pragma unroll
            for (int j = 0; j < 4; ++j) gl[j] = lg[j] * rs + brg[j];
#pragma unroll
            for (int j = 1; j < 4; ++j) if (gl[j] > gl[grp]) grp = j;
            float gs = 0.f;
#pragma unroll
            for (int j = 0; j < 4; ++j) gs += __expf(gl[j] - gl[grp]);
            const float pg = 1.f / gs;
            float el[4];
#pragma unroll
            for (int j = 0; j < 4; ++j) { float v = 0.f;
#pragma unroll
                for (int q = 0; q < 4; ++q) if (q == grp) v = lg[4 + q * 4 + j] * rs + bre[q * 4 + j];
                el[j] = v; }
            int i0 = 0;
#pragma unroll
            for (int j = 1; j < 4; ++j) if (el[j] > el[i0]) i0 = j;
            int i1 = (i0 == 0) ? 1 : 0;
#pragma unroll
            for (int j = 0; j < 4; ++j) if (j != i0 && el[j] > el[i1]) i1 = j;
            const float w0 = 1.f / (1.f + __expf(el[i1] - el[i0])), w1 = 1.f - w0;
            const int plo = i0 < i1 ? i0 : i1, phi = i0 < i1 ? i1 : i0;
            const float wlo = (i0 < i1 ? w0 : w1) * pg, whi = (i0 < i1 ? w1 : w0) * pg;
            const int pidx = (plo == 0) ? (phi - 1) : ((plo == 1) ? (phi + 1) : 5);
            const int bk = grp * 6 + pidx;
            *(f32x4*)(RW + t * 4) = (f32x4){wlo, whi, rs, 0.f};
            int lpos = 0; unsigned mycnt = 0;
#pragma unroll 1
            for (int b = 0; b < 24; ++b) {
                const unsigned long long mk = __ballot(bk == b);
                if (bk == b) lpos = __popcll(mk & ((1ull << lane) - 1ull));
                if (lane == b) mycnt = (unsigned)__popcll(mk);
            }
            unsigned base = 0;
            if (mycnt > 0) base = __hip_atomic_fetch_add(BCNT + lane, mycnt, __ATOMIC_RELAXED, __HIP_MEMORY_SCOPE_AGENT);
            const int pos = (int)__shfl(base, bk) + lpos;
            ROWTOKB[(size_t)bk * T + pos] = t;
        }
        __syncthreads();
    }
}
__device__ __forceinline__ float ld_f(const float* p) { return __hip_atomic_load(p, __ATOMIC_RELAXED, __HIP_MEMORY_SCOPE_AGENT); }
__device__ __forceinline__ float scan_add(float v, int lane) {
#pragma unroll
    for (int o = 1; o < 64; o <<= 1) { const float y = __int_as_float(__builtin_amdgcn_ds_bpermute(((lane - o) & 63) << 2, __float_as_int(v))); if (lane >= o) v += y; }
    return v;
}
__device__ __forceinline__ float scan_max(float v, int lane) {
#pragma unroll
    for (int o = 1; o < 64; o <<= 1) { const float y = __int_as_float(__builtin_amdgcn_ds_bpermute(((lane - o) & 63) << 2, __float_as_int(v))); if (lane >= o) v = fmaxf(v, y); }
    return v;
}
__device__ __forceinline__ float logsigf(float x) { return fminf(x, 0.f) - log1pf(__expf(-fabsf(x))); }
__device__ __forceinline__ void conv8(const bf16_t* proj, size_t tok, int tpos, const float* cw, const float* cb, int ch, float (&y)[8]) {
    const f32x4 b0 = *(const f32x4*)(cb + ch), b1 = *(const f32x4*)(cb + ch + 4);
#pragma unroll
    for (int j = 0; j < 4; ++j) { y[j] = b0[j]; y[4 + j] = b1[j]; }
#pragma unroll
    for (int j = 0; j < 4; ++j) {
        const int dt = 3 - j;
        if (tpos - dt >= 0) {
            const u32x4 r = *(const u32x4*)(proj + (tok - dt) * NPROJ + 768 + ch);
            float x[8]; unpack8(r, x);
            const f32x4 w0 = *(const f32x4*)(cw + j * 512 + ch), w1 = *(const f32x4*)(cw + j * 512 + ch + 4);
#pragma unroll
            for (int i = 0; i < 4; ++i) { y[i] += w0[i] * x[i]; y[4 + i] += w1[i] * x[4 + i]; }
        }
    }
#pragma unroll
    for (int i = 0; i < 8; ++i) y[i] = y[i] * __builtin_amdgcn_rcpf(1.f + __expf(-y[i]));
}


__device__ __forceinline__ void conv32(const bf16_t* proj, size_t tok, int tpos, const float* cw, const float* cb, int ch, float (&y)[32]) {
    u32x4 r[4][4];
#pragma unroll
    for (int j = 0; j < 4; ++j) {
        const int dt = 3 - j;
#pragma unroll
        for (int i = 0; i < 4; ++i) r[j][i] = (tpos - dt >= 0) ? *(const u32x4*)(proj + (tok - dt) * NPROJ + 768 + ch + i * 8) : (u32x4){0u, 0u, 0u, 0u};
    }
#pragma unroll
    for (int i = 0; i < 8; ++i) { const f32x4 b4 = *(const f32x4*)(cb + ch + i * 4);
#pragma unroll
        for (int e = 0; e < 4; ++e) y[i * 4 + e] = b4[e]; }
#pragma unroll
    for (int j = 0; j < 4; ++j)
#pragma unroll
        for (int i = 0; i < 4; ++i) {
            float x[8]; unpack8(r[j][i], x);
            const f32x4 w0 = *(const f32x4*)(cw + j * 512 + ch + i * 8), w1 = *(const f32x4*)(cw + j * 512 + ch + i * 8 + 4);
#pragma unroll
            for (int e = 0; e < 4; ++e) { y[i * 8 + e] += w0[e] * x[e]; y[i * 8 + 4 + e] += w1[e] * x[4 + e]; }
        }
#pragma unroll
    for (int i = 0; i < 32; ++i) y[i] = y[i] * __builtin_amdgcn_rcpf(1.f + __expf(-y[i]));
}

constexpr int KS_PITCH = 144, VT_PITCH = 528;
constexpr int AT_KS = 0, AT_VT = 256 * KS_PITCH, AT_BT = AT_VT + 64 * VT_PITCH;
__device__ __forceinline__ void attn_unit(const Args& a, const int l, LAS unsigned char* lds, const int unit, const int tid) {
    const bf16_t* proj = (const bf16_t*)(a.ws + FW_PROJ); bf16_t* mix = (bf16_t*)(a.ws + FW_MIX);
    const int wave = tid >> 6, lane = tid & 63, c = lane & 15, q = lane >> 4;
    const int b = unit >> 6, n = (unit >> 1) & 31, kvh = unit & 1;
    const size_t tok0 = (size_t)b * SEQ + n * 128;
    const int g = wave >> 1, rh = wave & 1, head = kvh * 4 + g;
    u32x4 qraw[4][2];
#pragma unroll
    for (int i = 0; i < 4; ++i)
#pragma unroll
        for (int ks = 0; ks < 2; ++ks) qraw[i][ks] = *(const u32x4*)(proj + (tok0 + (rh * 4 + i) * 16 + c) * NPROJ + head * 64 + ks * 32 + q * 8);
    {
        const int key = tid >> 1, half = tid & 1;
        const bool valid = (n > 0) || (key >= 128);
        const bf16_t* rowp = proj + (tok0 + key - 128) * NPROJ;
        u32x4 kr[4], vr[4];
#pragma unroll
        for (int i = 0; i < 4; ++i) { kr[i] = (u32x4){0u, 0u, 0u, 0u}; vr[i] = kr[i]; }
        if (valid) {
#pragma unroll
            for (int i = 0; i < 4; ++i) { kr[i] = *(const u32x4*)(rowp + 512 + kvh * 64 + half * 32 + i * 8); vr[i] = *(const u32x4*)(rowp + 640 + kvh * 64 + half * 32 + i * 8); }
        }
        float kf[4][8]; float ss = 0.f;
#pragma unroll
        for (int i = 0; i < 4; ++i) { unpack8(kr[i], kf[i]);
#pragma unroll
            for (int j = 0; j < 8; ++j) ss += kf[i][j] * kf[i][j]; }
        ss += __shfl_xor(ss, 1);
        const float rs = rsqrtf(ss * (1.f / 64.f) + 1e-6f);
        const float* kg = a.in[I_KG] + l * 64 + half * 32;
#pragma unroll
        for (int i = 0; i < 4; ++i) {
#pragma unroll
            for (int j = 0; j < 8; ++j) kf[i][j] *= rs * kg[i * 8 + j];
            *(LAS bf16x8*)(lds + AT_KS + key * KS_PITCH + half * 64 + i * 16) = pack8(kf[i]);
        }
#pragma unroll
        for (int i = 0; i < 4; ++i) {
            const unsigned w4[4] = {vr[i].x, vr[i].y, vr[i].z, vr[i].w};
#pragma unroll
            for (int j = 0; j < 4; ++j) {
                *(LAS bf16_t*)(lds + AT_VT + (half * 32 + i * 8 + 2 * j) * VT_PITCH + key * 2) = (bf16_t)(w4[j] & 0xffffu);
                *(LAS bf16_t*)(lds + AT_VT + (half * 32 + i * 8 + 2 * j + 1) * VT_PITCH + key * 2) = (bf16_t)(w4[j] >> 16);
            }
        }
        const int h4 = tid >> 7, dist = tid & 127;
        LAS float* bt = (LAS float*)(lds + AT_BT) + h4 * 384;
        bt[128 + dist] = a.in[I_RELB][t5_bucket(dist) * 8 + kvh * 4 + h4] * 1.4426950408889634f;
        bt[dist] = -INFINITY; bt[256 + dist] = -INFINITY;
    }
    __syncthreads();
    const float sink = a.in[I_SINK][l * 8 + head] * 1.4426950408889634f;
    const float* qg = a.in[I_QG] + l * 64;
    const LAS float* btab = (const LAS float*)(lds + AT_BT) + g * 384;
#pragma unroll 1
    for (int i = 0; i < 4; ++i) {
        const int tb = rh * 4 + i, tt = tb * 16 + c;
        const size_t tq = tok0 + tt;
        bf16x8 qf[2];
        {
            float qv[2][8]; float ss = 0.f;
#pragma unroll
            for (int ks = 0; ks < 2; ++ks) { unpack8(qraw[0][ks], qv[ks]);
#pragma unroll
                for (int j = 0; j < 8; ++j) ss += qv[ks][j] * qv[ks][j]; }
            ss += __shfl_xor(ss, 16); ss += __shfl_xor(ss, 32);
            const float rs = rsqrtf(ss * (1.f / 64.f) + 1e-6f) * (0.125f * 1.4426950408889634f);
#pragma unroll
            for (int ks = 0; ks < 2; ++ks) {
#pragma unroll
                for (int j = 0; j < 8; ++j) qv[ks][j] *= rs * qg[ks * 32 + q * 8 + j];
                qf[ks] = pack8(qv[ks]); }
#pragma unroll
            for (int j = 0; j < 3; ++j) { qraw[j][0] = qraw[j + 1][0]; qraw[j][1] = qraw[j + 1][1]; }
        }
        const int sb0 = tb & ~1;
        f32x4 acc[10];
#pragma unroll
        for (int x = 0; x < 10; ++x) {
            acc[x] = (f32x4){0.f, 0.f, 0.f, 0.f};
#pragma unroll
            for (int ks = 0; ks < 2; ++ks) { const bf16x8 kf = *(const LAS bf16x8*)(lds + AT_KS + ((sb0 + x) * 16 + c) * KS_PITCH + ks * 64 + q * 16);
                acc[x] = __builtin_amdgcn_mfma_f32_16x16x32_bf16(kf, qf[ks], acc[x], 0, 0, 0); }
        }
        float m = -INFINITY;
        const LAS float* bp = btab + (128 + tt + 128 - sb0 * 16 - 4 * q);
#pragma unroll
        for (int x = 0; x < 10; ++x)
#pragma unroll
            for (int r = 0; r < 4; ++r) { const float lg = acc[x][r] + bp[-(x * 16 + r)]; acc[x][r] = lg; }
        if (n == 0) {
#pragma unroll
            for (int x = 0; x < 10; ++x)
#pragma unroll
                for (int r = 0; r < 4; ++r) { const int kk = (sb0 + x) * 16 + 4 * q + r; if (kk < 128) acc[x][r] = -INFINITY; }
        }
#pragma unroll
        for (int x = 0; x < 10; ++x)
#pragma unroll
            for (int r = 0; r < 4; ++r) m = fmaxf(m, acc[x][r]);
        m = fmaxf(m, __shfl_xor(m, 16)); m = fmaxf(m, __shfl_xor(m, 32)); m = fmaxf(m, sink);
        float sum = 0.f;
#pragma unroll
        for (int x = 0; x < 10; ++x)
#pragma unroll
            for (int r = 0; r < 4; ++r) { const float p = __builtin_amdgcn_exp2f(acc[x][r] - m); acc[x][r] = p; sum += p; }
        sum += __shfl_xor(sum, 16); sum += __shfl_xor(sum, 32);
        const float inv = 1.f / (sum + __builtin_amdgcn_exp2f(sink - m));
        bf16x8 pf[5];
#pragma unroll
        for (int kp = 0; kp < 5; ++kp) { float f[8];
#pragma unroll
            for (int r = 0; r < 4; ++r) { f[r] = acc[2 * kp][r] * inv; f[4 + r] = acc[2 * kp + 1][r] * inv; }
            pf[kp] = pack8(f); }
#pragma unroll
        for (int db = 0; db < 4; ++db) {
            f32x4 o = (f32x4){0.f, 0.f, 0.f, 0.f};
#pragma unroll
            for (int kp = 0; kp < 5; ++kp) {
                const LAS unsigned char* vp = lds + AT_VT + (db * 16 + c) * VT_PITCH + (sb0 * 16 + 32 * kp + 4 * q) * 2;
                const u32x2 lo = *(const LAS u32x2*)vp, hi = *(const LAS u32x2*)(vp + 32);
                const u32x4 vv = (u32x4){lo.x, lo.y, hi.x, hi.y};
                o = __builtin_amdgcn_mfma_f32_16x16x32_bf16(__builtin_bit_cast(bf16x8, vv), pf[kp], o, 0, 0, 0);
            }
            u32x2 w; w.x = cvt_pk_bf16(o[0], o[1]); w.y = cvt_pk_bf16(o[2], o[3]);
            *(u32x2*)(mix + tq * D + head * 64 + db * 16 + 4 * q) = w;
        }
    }
    __syncthreads();
}

constexpr int ML_PITCH = 144;
constexpr int MA_VT = 0, MA_KT = 4 * 128 * ML_PITCH, MA_W = MA_KT + 4 * 64 * ML_PITCH;
__device__ __forceinline__ void stage_vt(const bf16_t* proj, size_t t0, LAS unsigned char* vt, int tid) {
    const int s = tid & 63, vg = tid >> 6;
    const bf16_t* rowp = proj + (t0 + s) * NPROJ + 1280 + vg * 64;
#pragma unroll
    for (int i = 0; i < 8; ++i) {
        const u32x4 r = *(const u32x4*)(rowp + i * 8);
        const unsigned w4[4] = {r.x, r.y, r.z, r.w};
#pragma unroll
        for (int j = 0; j < 4; ++j) {
            *(LAS bf16_t*)(vt + (vg * 64 + i * 8 + 2 * j) * ML_PITCH + s * 2) = (bf16_t)(w4[j] & 0xffffu);
            *(LAS bf16_t*)(vt + (vg * 64 + i * 8 + 2 * j + 1) * ML_PITCH + s * 2) = (bf16_t)(w4[j] >> 16);
        }
    }
}
__device__ __forceinline__ void mlstm_a_unit(const Args& a, const int l, LAS unsigned char* lds, const int unit, const int tid) {
    const bf16_t* proj = (const bf16_t*)(a.ws + FW_PROJ); const float* gates = (const float*)(a.ws + FW_GATES);
    const int wave = tid >> 6, lane = tid & 63, c = lane & 15, q = lane >> 4;
    const int b = unit >> 6, ck = unit & 63;
    const size_t t0 = (size_t)b * SEQ + ck * 64;
    LAS float* wS = (LAS float*)(lds + MA_W);
    if (wave < 4) {
        const int h = wave; const size_t t = t0 + lane;
        const float li = gates[t * 8 + h], lf = logsigf(gates[t * 8 + 4 + h]);
        const float bc = scan_add(lf, lane), blast = __shfl(bc, 63);
        const float logw = blast - bc + li, ac = wave_max(logw);
        wS[h * 64 + lane] = __expf(logw - ac);
        if (lane == 0) { float* sc = (float*)(a.ws + FW_SC) + ((size_t)(b * 4 + h) * 64 + ck) * 2; sc[0] = blast; sc[1] = ac; }
    }
    __syncthreads();
    {
        const int s = tid & 63, cg = tid >> 6, head = cg >> 1;
        const float wv = wS[head * 64 + s] * 0.125f;
        const float* cw = a.in[I_CONVW] + l * 2048; const float* cb = a.in[I_CONVB] + l * 512;
        float y[32];
        conv32(proj, t0 + s, ck * 64 + s, cw, cb, 256 + cg * 32, y);
#pragma unroll
        for (int j = 0; j < 32; ++j) *(LAS bf16_t*)(lds + MA_KT + (cg * 32 + j) * ML_PITCH + s * 2) = f2bf(y[j] * wv);
        stage_vt(proj, t0, lds + MA_VT, tid);
    }
    __syncthreads();
    {
        const int head = wave >> 1, vh = wave & 1, bh = b * 4 + head;
        f32x4 acc[4][4];
#pragma unroll
        for (int db = 0; db < 4; ++db)
#pragma unroll
            for (int vb = 0; vb < 4; ++vb) acc[db][vb] = (f32x4){0.f, 0.f, 0.f, 0.f};
#pragma unroll
        for (int ks = 0; ks < 2; ++ks) {
            bf16x8 vf[4];
#pragma unroll
            for (int vb = 0; vb < 4; ++vb) vf[vb] = *(const LAS bf16x8*)(lds + MA_VT + (head * 128 + vh * 64 + vb * 16 + c) * ML_PITCH + ks * 64 + q * 16);
#pragma unroll
            for (int db = 0; db < 4; ++db) {
                const bf16x8 kf = *(const LAS bf16x8*)(lds + MA_KT + (head * 64 + db * 16 + c) * ML_PITCH + ks * 64 + q * 16);
#pragma unroll
                for (int vb = 0; vb < 4; ++vb) acc[db][vb] = __builtin_amdgcn_mfma_f32_16x16x32_bf16(kf, vf[vb], acc[db][vb], 0, 0, 0);
            }
        }
        bf16_t* U = (bf16_t*)((unsigned char*)a.out + OUT_USTATE) + ((size_t)bh * 64 + ck) * 8192;
#pragma unroll
        for (int db = 0; db < 4; ++db)
#pragma unroll
            for (int vb = 0; vb < 4; ++vb) { u32x2 w; w.x = cvt_pk_bf16(acc[db][vb][0], acc[db][vb][1]); w.y = cvt_pk_bf16(acc[db][vb][2], acc[db][vb][3]);
                *(u32x2*)(U + (vh * 64 + vb * 16 + c) * 64 + db * 16 + 4 * q) = w; }
        if (vh == 0) {
            float nn = 0.f; const LAS bf16_t* kr = (const LAS bf16_t*)(lds + MA_KT + (head * 64 + lane) * ML_PITCH);
            for (int s = 0; s < 64; ++s) nn += bf2f(kr[s]);
            ((float*)(a.ws + FW_NIN))[((size_t)bh * 64 + ck) * 64 + lane] = nn;
        }
    }
    __syncthreads();
}
__device__ __forceinline__ void mlstm_scan_item(const Args& a, LAS unsigned char* lds, const int item, const int tid) {
    const int bh = item >> 4, slice = item & 15, elem = slice * 512 + tid;
    LAS float* scs = (LAS float*)lds;
    if (tid < 128) scs[tid] = ld_f((const float*)(a.ws + FW_SC) + (size_t)bh * 128 + tid);
    __syncthreads();
    const bf16_t* U = (const bf16_t*)((const unsigned char*)a.out + OUT_USTATE) + (size_t)bh * 64 * 8192 + elem;
    bf16_t* Cst = (bf16_t*)((unsigned char*)a.out + OUT_CSTATE) + (size_t)bh * 64 * 8192 + elem;
    const float* nin = (const float*)(a.ws + FW_NIN) + (size_t)bh * 64 * 64 + tid; float* nst = (float*)(a.ws + FW_NST) + (size_t)bh * 64 * 64 + tid;
    float* mst = (float*)(a.ws + FW_MST) + bh * 64;
    const bool do_n = (slice == 0) && (tid < 64);
    float m = 0.f, C = 0.f, nv = 0.f;
    {
        float u[64], un[64];
#pragma unroll
        for (int j = 0; j < 64; ++j) { u[j] = bf2f(__builtin_nontemporal_load(U + (size_t)j * 8192)); un[j] = do_n ? __builtin_nontemporal_load(nin + j * 64) : 0.f; }
#pragma unroll
        for (int j = 0; j < 64; ++j) {
            const int ck = j; const float blast = scs[ck * 2], ac = scs[ck * 2 + 1];
            const float mn = fmaxf(blast + m, ac), dec = __expf(blast + m - mn), sc = __expf(ac - mn);
            Cst[(size_t)ck * 8192] = f2bf(C);
            if (do_n) nst[ck * 64] = nv;
            if (slice == 0 && tid == 0) mst[ck] = m;
            C = dec * C + sc * u[j]; nv = dec * nv + sc * un[j]; m = mn;
        }
    }
    __syncthreads();
}
constexpr int MC_KS = 0, MC_VT = 4 * 64 * ML_PITCH, MC_TAB = MC_VT + 4 * 128 * ML_PITCH;
__device__ __forceinline__ void mlstm_c_unit(const Args& a, const int l, LAS unsigned char* lds, const int unit, const int tid) {
    const bf16_t* proj = (const bf16_t*)(a.ws + FW_PROJ); const float* gates = (const float*)(a.ws + FW_GATES); bf16_t* mix = (bf16_t*)(a.ws + FW_MIX);
    const int wave = tid >> 6, lane = tid & 63, c = lane & 15, q = lane >> 4;
    const int b = unit >> 6, ck = unit & 63;
    const size_t t0 = (size_t)b * SEQ + ck * 64;
    const float* cw = a.in[I_CONVW] + l * 2048; const float* cb = a.in[I_CONVB] + l * 512;
    const int head = wave >> 1, th = wave & 1, bh = b * 4 + head;
    LAS float* tabB = (LAS float*)(lds + MC_TAB) + wave * 192; LAS float* tabG = tabB + 64; LAS float* tabM = tabB + 128;
    const float mc = ld_f((const float*)(a.ws + FW_MST) + bh * 64 + ck);
    {
        const size_t t = t0 + lane;
        const float li = gates[t * 8 + head], lf = logsigf(gates[t * 8 + 4 + head]);
        const float bc = scan_add(lf, lane), gg = li - bc, G = scan_max(gg, lane);
        tabB[lane] = bc; tabG[lane] = gg; tabM[lane] = fmaxf(mc, G);
    }
    const float* nst = (const float*)(a.ws + FW_NST) + ((size_t)bh * 64 + ck) * 64;
    f32x4 nv[2][2];
#pragma unroll
    for (int ks = 0; ks < 2; ++ks) { nv[ks][0] = __builtin_nontemporal_load((const f32x4*)(nst + ks * 32 + q * 8)); nv[ks][1] = __builtin_nontemporal_load((const f32x4*)(nst + ks * 32 + q * 8 + 4)); }
    bf16x8 qf[2][2]; float nq[2];
#pragma unroll
    for (int ti = 0; ti < 2; ++ti) {
        const int t = (th * 2 + ti) * 16 + c; float part = 0.f;
#pragma unroll
        for (int ks = 0; ks < 2; ++ks) { float y[8]; conv8(proj, t0 + t, ck * 64 + t, cw, cb, head * 64 + ks * 32 + q * 8, y);
#pragma unroll
            for (int j = 0; j < 4; ++j) part += y[j] * nv[ks][0][j] + y[4 + j] * nv[ks][1][j];
            qf[ti][ks] = pack8(y); }
        part += __shfl_xor(part, 16); part += __shfl_xor(part, 32); nq[ti] = part;
        asm volatile("" ::: "memory");
    }
    const bf16_t* Cst = (const bf16_t*)((const unsigned char*)a.out + OUT_CSTATE) + ((size_t)bh * 64 + ck) * 8192;
    {
        const int s = tid & 63, cg = tid >> 6;
        float y[32];
        conv32(proj, t0 + s, ck * 64 + s, cw, cb, 256 + cg * 32, y);
#pragma unroll
        for (int i = 0; i < 4; ++i) { float z[8];
#pragma unroll
            for (int j = 0; j < 8; ++j) z[j] = y[i * 8 + j] * 0.125f;
            *(LAS bf16x8*)(lds + MC_KS + ((cg >> 1) * 64 + s) * ML_PITCH + ((cg & 1) * 32 + i * 8) * 2) = pack8(z); }
        stage_vt(proj, t0, lds + MC_VT, tid);
    }
    u32x4 cfr[8][2];
#pragma unroll
    for (int vb = 0; vb < 8; ++vb)
#pragma unroll
        for (int ks = 0; ks < 2; ++ks) cfr[vb][ks] = __builtin_nontemporal_load((const u32x4*)(Cst + (vb * 16 + c) * 64 + ks * 32 + q * 8));
    __syncthreads();
    int c2 = c, q2 = q; asm volatile("" : "+v"(c2), "+v"(q2));
    f32x4 as[4][2];
#pragma unroll
    for (int sb = 0; sb < 4; ++sb)
#pragma unroll
        for (int ti = 0; ti < 2; ++ti) {
            as[sb][ti] = (f32x4){0.f, 0.f, 0.f, 0.f};
#pragma unroll
            for (int ks = 0; ks < 2; ++ks) { const bf16x8 kf = *(const LAS bf16x8*)(lds + MC_KS + (head * 64 + sb * 16 + c2) * ML_PITCH + ks * 64 + q2 * 16);
                as[sb][ti] = __builtin_amdgcn_mfma_f32_16x16x32_bf16(kf, qf[ti][ks], as[sb][ti], 0, 0, 0); }
        }
    float Mt[2], isc[2], rsum[2], bt[2];
#pragma unroll
    for (int ti = 0; ti < 2; ++ti) { const int t = (th * 2 + ti) * 16 + c2; Mt[ti] = tabM[t]; bt[ti] = tabB[t]; isc[ti] = __expf(mc - Mt[ti]); rsum[ti] = 0.f; }
#pragma unroll
    for (int sb = 0; sb < 4; ++sb)
#pragma unroll
        for (int r = 0; r < 4; ++r) { const int s = sb * 16 + 4 * q2 + r; const float gs = tabG[s];
#pragma unroll
            for (int ti = 0; ti < 2; ++ti) { const int t = (th * 2 + ti) * 16 + c2; const float dv = (s <= t) ? __expf(gs - Mt[ti]) : 0.f; const float v = as[sb][ti][r] * dv; as[sb][ti][r] = v; rsum[ti] += v; } }
    bf16x8 sf[2][2];
#pragma unroll
    for (int ti = 0; ti < 2; ++ti) { rsum[ti] += __shfl_xor(rsum[ti], 16); rsum[ti] += __shfl_xor(rsum[ti], 32);
#pragma unroll
        for (int kp = 0; kp < 2; ++kp) { float f[8];
#pragma unroll
            for (int r = 0; r < 4; ++r) { f[r] = as[2 * kp][ti][r]; f[4 + r] = as[2 * kp + 1][ti][r]; }
            sf[ti][kp] = pack8(f); } }
    f32x4 an[8][2];
#pragma unroll
    for (int vb = 0; vb < 8; ++vb) {
        an[vb][0] = (f32x4){0.f, 0.f, 0.f, 0.f}; an[vb][1] = an[vb][0];
#pragma unroll
        for (int ks = 0; ks < 2; ++ks) { const bf16x8 cf = __builtin_bit_cast(bf16x8, cfr[vb][ks]);
#pragma unroll
            for (int ti = 0; ti < 2; ++ti) an[vb][ti] = __builtin_amdgcn_mfma_f32_16x16x32_bf16(cf, qf[ti][ks], an[vb][ti], 0, 0, 0); }
#pragma unroll
        for (int ti = 0; ti < 2; ++ti) an[vb][ti] = an[vb][ti] * isc[ti];
#pragma unroll
        for (int kp = 0; kp < 2; ++kp) {
            const LAS unsigned char* vp = lds + MC_VT + (head * 128 + vb * 16 + c2) * ML_PITCH + (32 * kp + 4 * q2) * 2;
            const u32x2 lo = *(const LAS u32x2*)vp, hi = *(const LAS u32x2*)(vp + 32);
            const bf16x8 vf = __builtin_bit_cast(bf16x8, ((u32x4){lo.x, lo.y, hi.x, hi.y}));
#pragma unroll
            for (int ti = 0; ti < 2; ++ti) an[vb][ti] = __builtin_amdgcn_mfma_f32_16x16x32_bf16(vf, sf[ti][kp], an[vb][ti], 0, 0, 0);
        }
    }
    const float* mg = a.in[I_MNORMG] + l * 512 + head * 128;
#pragma unroll
    for (int ti = 0; ti < 2; ++ti) {
        const int t = (th * 2 + ti) * 16 + c2; const size_t tok = t0 + t;
        u32x2 orw[8];
#pragma unroll
        for (int vb = 0; vb < 8; ++vb) orw[vb] = *(const u32x2*)(proj + tok * NPROJ + 1792 + head * 128 + vb * 16 + 4 * q2);
        const float den = isc[ti] * nq[ti] + rsum[ti], dn = 1.f / fmaxf(fabsf(den), __expf(-(bt[ti] + Mt[ti])));
        float ss = 0.f;
#pragma unroll
        for (int vb = 0; vb < 8; ++vb) { an[vb][ti] = an[vb][ti] * dn; ss += (an[vb][ti][0] * an[vb][ti][0] + an[vb][ti][1] * an[vb][ti][1]) + (an[vb][ti][2] * an[vb][ti][2] + an[vb][ti][3] * an[vb][ti][3]); }
        ss += __shfl_xor(ss, 16); ss += __shfl_xor(ss, 32);
        const float rs = rsqrtf(ss * (1.f / 128.f) + 1e-6f);
#pragma unroll
        for (int vb = 0; vb < 8; ++vb) {
            const int v0 = vb * 16 + 4 * q2;
            const float o4[4] = {__uint_as_float(orw[vb].x << 16), __uint_as_float(orw[vb].x & 0xffff0000u), __uint_as_float(orw[vb].y << 16), __uint_as_float(orw[vb].y & 0xffff0000u)};
            const f32x4 g4 = *(const f32x4*)(mg + v0);
            float r4[4];
#pragma unroll
            for (int j = 0; j < 4; ++j) r4[j] = an[vb][ti][j] * rs * g4[j] * __builtin_amdgcn_rcpf(1.f + __expf(-o4[j]));
            u32x2 w; w.x = cvt_pk_bf16(r4[0], r4[1]); w.y = cvt_pk_bf16(r4[2], r4[3]);
            *(u32x2*)(mix + tok * D + 512 + head * 128 + v0) = w;
        }
    }
    __syncthreads();
}

__device__ __forceinline__ void tr_item(const float* W, int ldw, int nvalid, int k0, int n0, bf16_t* dst, int dpitch, int drow0, LAS float* scr, int lane, const float* gk) {
    const int nn = n0 + (lane & 31);
    const float* wp = W + (size_t)(k0 + (lane >> 5)) * ldw + nn;
    float v[32];
    if (nn < nvalid) {
#pragma unroll
        for (int i = 0; i < 32; ++i) v[i] = __builtin_nontemporal_load(wp + (size_t)(2 * i) * ldw);
    } else {
#pragma unroll
        for (int i = 0; i < 32; ++i) v[i] = 0.f;
    }
    const int c = lane & 7;
    f32x4 g0 = (f32x4){1.f, 1.f, 1.f, 1.f}, g1 = g0;
    if (gk) { g0 = *(const f32x4*)(gk + k0 + 8 * c); g1 = *(const f32x4*)(gk + k0 + 8 * c + 4); }
#pragma unroll
    for (int i = 0; i < 32; ++i) scr[(2 * i + (lane >> 5)) * 33 + (lane & 31)] = v[i];
    asm volatile("s_waitcnt lgkmcnt(0)" ::: "memory");
#pragma unroll
    for (int j = 0; j < 4; ++j) { const int n = (lane >> 3) + 8 * j; const LAS float* s = scr + (8 * c) * 33 + n;
        u32x4 o; o.x = pk2(s[0 * 33] * g0[0], s[1 * 33] * g0[1]); o.y = pk2(s[2 * 33] * g0[2], s[3 * 33] * g0[3]); o.z = pk2(s[4 * 33] * g1[0], s[5 * 33] * g1[1]); o.w = pk2(s[6 * 33] * g1[2], s[7 * 33] * g1[3]);
        *(u32x4*)(dst + (size_t)(drow0 + n) * dpitch + k0 + 8 * c) = o; }
    asm volatile("s_waitcnt lgkmcnt(0)" ::: "memory");
}
__device__ __forceinline__ void norm_row(const float* xrow, bf16_t* orow, float* ssqrow, int lane) {
    const f32x4* xr = (const f32x4*)xrow + lane;
    f32x4 v[4]; float s = 0.f;
#pragma unroll
    for (int j = 0; j < 4; ++j) { v[j] = xr[64 * j]; s += (v[j][0] * v[j][0] + v[j][1] * v[j][1]) + (v[j][2] * v[j][2] + v[j][3] * v[j][3]); }
    s = wave_sum(s);
    u32x2* o8 = (u32x2*)orow + lane;
#pragma unroll
    for (int j = 0; j < 4; ++j) { u32x2 w; w.x = pk2(v[j][0], v[j][1]); w.y = pk2(v[j][2], v[j][3]); o8[64 * j] = w; }
    if (lane < 16) ssqrow[lane] = (lane == 0) ? s : 0.f;
}

constexpr int CV_IN = 16 * 80, CV_OUT = 16 * 32, CV_G = 16 * 16 * 16, CV_D = 16 * 8 * 32, CV_LAYER = CV_IN + CV_OUT + 2 * CV_G + CV_D;
__device__ __forceinline__ void conv_item(const Args& a, int it, LAS float* scr, int lane) {
    unsigned char* ws = a.ws;
    const int l = it / CV_LAYER; int r = it % CV_LAYER;
    if (r < CV_IN) { const int kb = r / 80, nb = r % 80;
        tr_item(a.in[I_WIN] + (size_t)l * D * NIN, NIN, NIN, kb * 64, nb * 32, (bf16_t*)(ws + FW_WIN) + (size_t)l * WIN_ROWS * 1024, 1024, nb * 32, scr, lane, a.in[I_NMIXG] + l * D); return; }
    r -= CV_IN;
    if (r < CV_OUT) { const int kb = r / 32, nb = r % 32;
        tr_item(a.in[I_WOUT] + (size_t)l * D * D, D, D, kb * 64, nb * 32, (bf16_t*)(ws + FW_WOUT) + (size_t)l * 1024 * 1024, 1024, nb * 32, scr, lane, nullptr); return; }
    r -= CV_OUT;
    if (r < 2 * CV_G) { const int up = r / CV_G; r %= CV_G; const int e = r / 256, kb = (r % 256) / 16, nb = r % 16, n0 = nb * 32;
        const float* src = a.in[up ? I_WUP : I_WGATE] + ((size_t)l * 16 + e) * 1024 * 512;
        tr_item(src, 512, 512, kb * 64, n0, (bf16_t*)(ws + FW_WGU) + ((size_t)l * 16 + e) * 1024 * 1024, 1024, 256 * (n0 / 128) + (n0 % 128) + (up ? 128 : 0), scr, lane, a.in[I_NFFNG] + l * D); return; }
    r -= 2 * CV_G;
    { const int e = r / 256, kb = (r % 256) / 32, nb = r % 32;
        tr_item(a.in[I_WDOWN] + ((size_t)l * 16 + e) * 512 * 1024, 1024, 1024, kb * 64, nb * 32, (bf16_t*)(ws + FW_WD) + ((size_t)l * 16 + e) * 1024 * 512, 512, nb * 32, scr, lane, nullptr); }
}
__device__ __forceinline__ void conv_work(const Args& a, LAS unsigned char* lds, int begin, int end, int qword, int tid) {
    unsigned* counter = (unsigned*)(a.ws + FW_CTL) + CW_CONVQ + 64 * qword;
    LAS int* slot = (LAS int*)(lds + MISC_OFF + 8192);
    const int wave = __builtin_amdgcn_readfirstlane(tid >> 6), lane = tid & 63;
    LAS float* scr = (LAS float*)(lds + wave * 16384);
    for (;;) {
        __syncthreads();
        if (tid == 0) *slot = (int)__hip_atomic_fetch_add(counter, 1u, __ATOMIC_RELAXED, __HIP_MEMORY_SCOPE_AGENT);
        __syncthreads();
        const int base = begin + (*slot) * 16;
        if (base >= end) break;
#pragma unroll 1
        for (int j = 0; j < 2; ++j) { const int it = base + wave * 2 + j; if (it < end) conv_item(a, it, scr, lane); }
    }
}

constexpr int NPHASES = 15;

__device__ __forceinline__ void p0_prologue(const Args& a, LAS unsigned char* lds, int vcu, int G, int tid) {
    unsigned char* ws = a.ws;
    const int wave = __builtin_amdgcn_readfirstlane(tid >> 6), lane = tid & 63;
    const int gw = vcu * NWAVES + wave, NGW = G * NWAVES;
    for (int m = gw; m < T; m += NGW) norm_row(a.in[I_X] + (size_t)m * D, (bf16_t*)(ws + FW_XG) + (size_t)m * D, (float*)(ws + FW_SSQ) + (size_t)m * 16, lane);
    for (int idx = (int)blockIdx.x * NTHR + tid; idx < 2 * 24 * 1024; idx += G * NTHR) {
        const int l = idx / (24 * 1024), j = (idx / 1024) % 24, k = idx & 1023;
        float v = 0.f; if (j < 4) v = a.in[I_WRG][((size_t)l * D + k) * 4 + j]; else if (j < 20) v = a.in[I_WRE][((size_t)l * D + k) * 16 + (j - 4)];
        v *= a.in[I_NFFNG][l * D + k];
        const bf16_t h = f2bf(v), lo = f2bf(v - bf2f(h));
        bf16_t* rt = (bf16_t*)(ws + FW_RT) + (size_t)l * 48 * 1024;
        rt[j * 1024 + k] = h; rt[(24 + j) * 1024 + k] = lo;
    }
    conv_work(a, lds, 0, CV_IN, 0, tid);
}

#define XB_TMO      128
#define XB_XCNT(j)  (256  + 64 * (j))
#define XB_XSUB(j)  (1280 + 64 * (j))
#define XB_XGEN(j)  (2304 + 64 * (j))
#define XB_TOP      3328
#define XB_TOPGEN   3392
#define XCD_BAR_WORDS 3456
#define XB_SPIN_CAP (1u << 18)
__device__ __forceinline__ unsigned xb_ld(unsigned* p)              { return __hip_atomic_load(p, __ATOMIC_RELAXED, __HIP_MEMORY_SCOPE_AGENT); }
__device__ __forceinline__ unsigned xb_add(unsigned* p, unsigned v) { return __hip_atomic_fetch_add(p, v, __ATOMIC_RELAXED, __HIP_MEMORY_SCOPE_AGENT); }
__device__ __forceinline__ unsigned xb_xcc_id() { return (unsigned)__builtin_amdgcn_s_getreg((3 << 11) | 20) & 0xFu; }
#define XB_SPIN(cond, bar) do { unsigned _sp = 0; while (cond) { __builtin_amdgcn_s_sleep(1); \
    if ((++_sp & 255u) == 0u) { if (xb_ld(&(bar)[XB_TMO])) break; if (_sp > XB_SPIN_CAP) { atomicAdd(&(bar)[XB_TMO], 1u); break; } } } } while (0)
struct XcdBarrier { unsigned* bar; unsigned x; volatile LAS unsigned* st; int swave; };
__device__ __forceinline__ XcdBarrier xcd_barrier_post(unsigned* bar, volatile LAS unsigned* st, bool tid0) {
    XcdBarrier b; b.bar = bar; b.x = xb_xcc_id(); b.st = st; b.swave = 0;
    if (tid0) (void)xb_add(&bar[XB_XCNT(b.x)], 1u);
    return b;
}
__device__ __forceinline__ void xcd_barrier_complete(unsigned* bar, unsigned x, unsigned& nloc, unsigned& nx) {
    const unsigned G = gridDim.x * gridDim.y * gridDim.z;
    unsigned sum, cnt, mine, sp = 0u;
    for (;;) {
        sum = 0u; cnt = 0u; mine = 0u;
#pragma unroll
        for (unsigned j = 0; j < 16; ++j) { const unsigned c = xb_ld(&bar[XB_XCNT(j)]); sum += c; cnt += (c > 0u) ? 1u : 0u; mine = (j == x) ? c : mine; }
        if (sum == G) break;
        __builtin_amdgcn_s_sleep(1);
        if ((++sp & 255u) == 0u) { if (xb_ld(&bar[XB_TMO])) break; if (sp > XB_SPIN_CAP) { atomicAdd(&bar[XB_TMO], 1u); break; } }
    }
    nloc = mine > 0u ? mine : 1u; nx = cnt > 0u ? cnt : 1u;
}
__device__ __forceinline__ void xcd_barrier(const XcdBarrier& b) {
    asm volatile("s_waitcnt vmcnt(0)" ::: "memory");
    __syncthreads();
    if (tid_of(b.swave) == 0) {
        unsigned* bar = b.bar;
        __builtin_amdgcn_s_waitcnt(0);
        unsigned nloc = b.st[0], nx = b.st[1];
        if (nloc == 0u) { xcd_barrier_complete(bar, b.x, nloc, nx); b.st[0] = nloc; b.st[1] = nx; }
        const unsigned old = xb_add(&bar[XB_XSUB(b.x)], 1u);
        const unsigned gen = old / nloc;
        if (old + 1u == (gen + 1u) * nloc) {
            __builtin_amdgcn_fence(__ATOMIC_RELEASE, "agent");
            asm volatile("s_waitcnt vmcnt(0)" ::: "memory");
            const unsigned og = xb_add(&bar[XB_TOP], 1u);
            const unsigned tg = og / nx;
            if (og + 1u == (tg + 1u) * nx) xb_add(&bar[XB_TOPGEN], 1u);
            else XB_SPIN(xb_ld(&bar[XB_TOPGEN]) == tg, bar);
            __builtin_amdgcn_fence(__ATOMIC_ACQUIRE, "agent");
            xb_add(&bar[XB_XGEN(b.x)], 1u);
            asm volatile("s_waitcnt vmcnt(0)" ::: "memory");
        } else {
            XB_SPIN(xb_ld(&bar[XB_XGEN(b.x)]) == gen, bar);
            __builtin_amdgcn_fence(__ATOMIC_ACQUIRE, "agent");
            asm volatile("s_waitcnt vmcnt(0)" ::: "memory");
        }
    }
    __syncthreads();
}

#define IN(k) (lo <= (k) && (k) < hi)
#define STAMP(k) do { } while (0)
#define SEAM(k) do { if (IN(k) && IN((k) + 1)) xcd_barrier(bar); STAMP((k) + 1); } while (0)
#ifndef MOE_SPLIT
#define MOE_SPLIT(layer, seg) 0
#endif
#define PHASE(k, ...) do { if (IN(k)) { __VA_ARGS__ } } while (0)
template <int L>
__device__ __forceinline__ void layer_phases(const Args& args, LAS unsigned char* lds, const int lo, const int hi, const int G, const int bx, const int vcu, const XcdBarrier& bar, const int swave) {
    unsigned char* ws = args.ws;
    constexpr int l = L, base = 1 + 7 * L;
    constexpr int Q0b = (L == 0) ? CV_IN : CV_LAYER + CV_IN + CV_OUT + CV_G, Q0e = (L == 0) ? CV_IN + CV_OUT + 2 * CV_G : 2 * CV_LAYER;
    constexpr int Q1b = (L == 0) ? CV_IN + CV_OUT + 2 * CV_G : 0, Q1e = (L == 0) ? CV_LAYER : 0;
    constexpr int Q6b = (L == 0) ? CV_LAYER : 0, Q6e = (L == 0) ? CV_LAYER + CV_IN + CV_OUT + CV_G : 0;
    PHASE(base + 0,
        DenseOrder S; S.init(T, WIN_ROWS, G, bx, ws + FW_XG, 1024, (bf16_t*)(ws + FW_WIN) + (size_t)l * WIN_ROWS * 1024, 1024);
        EpiInProj E{(const float*)(ws + FW_SSQ), (bf16_t*)(ws + FW_PROJ), (float*)(ws + FW_GATES), args.in[I_GATEB] + l * 8};
        gemm_phase<EpiInProj, DenseOrder, false>(lds, 1024, 1024, 16, S, E, swave);
        if (Q0e > Q0b) { int t_ = tid_of(swave); asm volatile("" : "+v"(t_)); conv_work(args, lds, Q0b, Q0e, base + 0, t_); }
    );
    SEAM(base + 0);
    PHASE(base + 1,
        for (int u = bx; u < 256; u += G) { int t_ = tid_of(swave); asm volatile("" : "+v"(t_)); attn_unit(args, l, lds, u, t_); }
        for (int u = bx; u < 256; u += G) { int t_ = tid_of(swave); asm volatile("" : "+v"(t_)); mlstm_a_unit(args, l, lds, u, t_); }
        if (Q1e > Q1b) { int t_ = tid_of(swave); asm volatile("" : "+v"(t_)); conv_work(args, lds, Q1b, Q1e, base + 1, t_); }
    );
    SEAM(base + 1);
    PHASE(base + 2, for (int u = bx; u < 256; u += G) { int t_ = tid_of(swave); asm volatile("" : "+v"(t_)); mlstm_scan_item(args, lds, u, t_); } );
    SEAM(base + 2);
    PHASE(base + 3, for (int u = bx; u < 256; u += G) { int t_ = tid_of(swave); asm volatile("" : "+v"(t_)); mlstm_c_unit(args, l, lds, u, t_); } );
    SEAM(base + 3);
    PHASE(base + 4,
        DenseOrder S; S.init(T, 1024, G, bx, ws + FW_MIX, 1024, (bf16_t*)(ws + FW_WOUT) + (size_t)l * 1024 * 1024, 1024);
        EpiResid<false, false> E{(bf16_t*)(ws + FW_XG), nullptr, (float*)(ws + FW_SSQ)};
        gemm_phase<EpiResid<false, false>, DenseOrder, false>(lds, 1024, 1024, 16, S, E, swave);
    );
    SEAM(base + 4);
    PHASE(base + 5, int t_ = tid_of(swave); asm volatile("" : "+v"(t_)); route1_phase(args, l, lds, bx, G, t_); );
    SEAM(base + 5);
    PHASE(base + 6,
        LAS int* tb = (LAS int*)(lds + MISC_OFF + 12288);
        if (tid_of(swave) == 0) { int run = 0; const int* bc = (const int*)(ws + FW_CTL) + CW_BCNT + 64 * l;
            for (int b = 0; b < 24; ++b) { const int cb = ld_ctl(bc + b); tb[b] = run; tb[32 + b] = cb; run += (cb + 255) >> 8; }
            tb[24] = run; }
        __syncthreads();
        MoeOrder S; S.ntile = __builtin_amdgcn_readfirstlane(tb[24]); S.nup8 = S.ntile; S.ndn4 = S.ntile; S.pad_ = 0; S.G = G; S.c = vcu; S.tb = tb; S.rowtokb = (const int*)(ws + FW_ROWTOKB); S.xb = (const char*)(ws + FW_XG);
        S.wgu = (const char*)((bf16_t*)(ws + FW_WGU) + (size_t)l * 16 * 1024 * 1024); S.act = (const char*)(ws + FW_PROJ); S.wd = (const char*)((bf16_t*)(ws + FW_WD) + (size_t)l * 16 * 1024 * 512);
        S.upcnt = (unsigned*)(ws + FW_CTL) + CW_UPCNT + 128 * l;
        EpiMoe<L == 1> E{EpiUp{(bf16_t*)(ws + FW_PROJ), (const float*)(ws + FW_RW), S.upcnt}, EpiResid<true, L == 1>{(bf16_t*)(ws + FW_XG), args.out, (float*)(ws + FW_SSQ)}};
        _Pragma("unroll 1") for (int seg = 0; seg < 2; ++seg) { S.nup8 = seg ? 0 : S.ntile; S.ndn4 = seg ? S.ntile : 0; S.pad_ = MOE_SPLIT(L, seg); gemm_phase<EpiMoe<L == 1>, MoeOrder, true>(lds, 1024, 1024, 16, S, E, swave); }
        if (Q6e > Q6b) { int t_ = tid_of(swave); asm volatile("" : "+v"(t_)); conv_work(args, lds, Q6b, Q6e, base + 6, t_); }
    );
    SEAM(base + 6);
}

__global__ void __launch_bounds__(NTHR, 2) fwd(Args args) {
    extern __shared__ __attribute__((aligned(16))) unsigned char lds_raw[];
    LAS unsigned char* lds = (LAS unsigned char*)lds_raw;
    const int G = gridDim.x; const int bx = blockIdx.x; const int vcu = (G % 8 == 0) ? (bx % 8) * (G / 8) + bx / 8 : bx;
    const int lo = args.ph_lo, hi = args.ph_hi;
    const int swave = __builtin_amdgcn_readfirstlane((int)threadIdx.x >> 6);
    volatile LAS unsigned* bst = (volatile LAS unsigned*)(lds + MISC_OFF + 4096);
    if (tid_of(swave) < 2) bst[tid_of(swave)] = 0u;
    __syncthreads();
    XcdBarrier bar; bar.bar = (unsigned*)(args.ws + FW_CTL) + CW_BAR; bar.x = 0; bar.st = bst; bar.swave = swave;
    if (hi - lo > 1) { bar = xcd_barrier_post((unsigned*)(args.ws + FW_CTL) + CW_BAR, bst, tid_of(swave) == 0); bar.swave = swave; }
    STAMP(0);
    PHASE(0, int t_ = tid_of(swave); asm volatile("" : "+v"(t_)); p0_prologue(args, lds, vcu, G, t_); );
    SEAM(0);
    layer_phases<0>(args, lds, lo, hi, G, bx, vcu, bar, swave);
    layer_phases<1>(args, lds, lo, hi, G, bx, vcu, bar, swave);
}
#undef IN
#undef SEAM
#undef PHASE
}

extern "C" void kernel_launch(void* const* d_in, const int* in_sizes, int n_in, void* d_out, int out_size, void* d_ws, size_t ws_size, hipStream_t stream) {
    static int grid = 0;
    if (grid == 0) {
        int dev = 0, cus = 0, per_cu = 0;
        if (hipGetDevice(&dev) != hipSuccess || hipDeviceGetAttribute(&cus, hipDeviceAttributeMultiprocessorCount, dev) != hipSuccess) { fprintf(stderr, "kernel_launch: device query failed\n"); grid = -1; return; }
        if (hipFuncSetAttribute((const void*)fk::fwd, hipFuncAttributeMaxDynamicSharedMemorySize, fk::LDS_BYTES) != hipSuccess) { fprintf(stderr, "kernel_launch: hipFuncSetAttribute failed\n"); grid = -1; return; }
        if (hipOccupancyMaxActiveBlocksPerMultiprocessor(&per_cu, (const void*)fk::fwd, fk::NTHR, fk::LDS_BYTES) != hipSuccess || per_cu < 1) { fprintf(stderr, "kernel_launch: occupancy query says %d blocks per CU\n", per_cu); per_cu = 1; }
        (void)hipGetLastError();
        grid = cus;
        fprintf(stderr, "kernel_launch: grid %d, per_cu %d, ws_size %zu\n", grid, per_cu, ws_size);
    }
    if (grid < 0) return;
    float* out = (float*)d_out;
    unsigned char* ws = (unsigned char*)d_ws;
    fk::Args a{};
    for (int i = 0; i < 20; ++i) a.in[i] = (const float*)d_in[i];
    a.out = out; a.ws = ws;
    (void)hipMemsetAsync(ws + fk::FW_CTL, 0, 64 * 1024, stream);
    auto run = [&](int lo, int hi) { a.ph_lo = lo; a.ph_hi = hi; hipLaunchKernelGGL(fk::fwd, dim3(grid), dim3(fk::NTHR), fk::LDS_BYTES, stream, a); };
    run(0, fk::NPHASES);
}
```

```cpp
#include <hip/hip_runtime.h>
#include <cstdio>
#include <cstdint>

typedef unsigned short bf16_t;
constexpr int T = 16384, SEQ = 4096, D = 1024, NIN = 2312, NPROJ = 2304;
constexpr size_t MiB = 1u << 20;

__device__ __forceinline__ float bf2f(bf16_t v) { return __uint_as_float((unsigned)v << 16); }
__device__ __forceinline__ bf16_t f2bf(float f) { unsigned u = __float_as_uint(f); return (bf16_t)((u + 0x7fffu + ((u >> 16) & 1u)) >> 16); }
__device__ __forceinline__ float wave_sum(float v) {
#pragma unroll
    for (int o = 1; o < 64; o <<= 1) v += __shfl_xor(v, o);
    return v;
}
__device__ __forceinline__ float wave_max(float v) {
#pragma unroll
    for (int o = 1; o < 64; o <<= 1) v = fmaxf(v, __shfl_xor(v, o));
    return v;
}
__device__ __forceinline__ float siluf(float x) { return x / (1.f + __expf(-x)); }
__device__ __forceinline__ float sigmoidf(float x) { return 1.f / (1.f + __expf(-x)); }

__device__ __forceinline__ int t5_bucket(int dist) {
    if (dist < 16) return dist;
    const float d = (float)dist;
    int large = 16 + (int)(logf(d / 16.f) / logf(8.f) * 16.f);
    return large < 31 ? large : 31;
}

namespace fk {
#define LAS __attribute__((address_space(3)))
typedef short bf16x8 __attribute__((ext_vector_type(8)));
typedef float f32x4 __attribute__((ext_vector_type(4)));
typedef float f32x2 __attribute__((ext_vector_type(2)));
typedef unsigned u32x4 __attribute__((ext_vector_type(4)));
typedef unsigned u32x2 __attribute__((ext_vector_type(2)));
constexpr int NWAVES = 8, NTHR = 512;
constexpr int BM = 256, BK = 64, HALF = 128, HTB = HALF * BK * 2, STAGE_BYTES = 8 * HTB;
constexpr int LDS_BYTES = 147456;
constexpr int MISC_OFF = STAGE_BYTES;
constexpr size_t FW_CTL = 0;
constexpr size_t FW_WIN = 1 * MiB;
constexpr size_t FW_WOUT = 11 * MiB;
constexpr size_t FW_WGU = 15 * MiB;
constexpr size_t FW_WD = 79 * MiB;
constexpr size_t FW_XG = 111 * MiB;
constexpr size_t FW_PROJ = 143 * MiB;
constexpr size_t FW_MIX = 215 * MiB;
constexpr size_t FW_SSQ = 247 * MiB;
constexpr size_t FW_GATES = 248 * MiB;
constexpr size_t FW_RB = 249 * MiB;
constexpr size_t FW_RW = FW_RB + 65536;
constexpr size_t FW_LPOS = FW_RW + 262144;
constexpr size_t FW_CNT = FW_LPOS + 65536;
constexpr size_t FW_ROWTOK = FW_CNT + 32768;
constexpr size_t FW_ROWW = FW_ROWTOK + 131072;
constexpr size_t FW_TILEB = FW_ROWW + 524288;
constexpr size_t FW_NIN = FW_TILEB + 4096;
constexpr size_t FW_NST = FW_NIN + 262144;
constexpr size_t FW_SC = FW_NST + 262144;
constexpr size_t FW_MST = FW_SC + 8192;
constexpr size_t FW_RT = FW_MST + 4096;
constexpr size_t OUT_USTATE = 0;
constexpr size_t OUT_CSTATE = 16 * MiB;
constexpr size_t FW_ROWTOKB = 252 * MiB;
constexpr int CW_CONVQ = 512, CW_BAR = 4096, CW_BCNT = 8192, CW_UPCNT = 8704;
constexpr int MAXROWS = 16384 + 24 * 256;
constexpr int WIN_ROWS = 2560;

__device__ __forceinline__ unsigned pk2(float lo, float hi) { return (unsigned)f2bf(lo) | ((unsigned)f2bf(hi) << 16); }
typedef __bf16 bf16x2_t __attribute__((ext_vector_type(2)));
__device__ __forceinline__ unsigned cvt_pk_op(float lo, float hi);
__device__ __forceinline__ unsigned cvt_pk_bf16(float lo, float hi) { return cvt_pk_op(lo, hi); }
__device__ __forceinline__ unsigned cvt_pk_op(float lo, float hi) { const f32x2 v = {lo, hi}; const bf16x2_t b = __builtin_convertvector(v, bf16x2_t); return __builtin_bit_cast(unsigned, b); }

__device__ __forceinline__ void unpack8(const u32x4 r, float (&f)[8]) {
    f[0] = __uint_as_float(r.x << 16); f[1] = __uint_as_float(r.x & 0xffff0000u); f[2] = __uint_as_float(r.y << 16); f[3] = __uint_as_float(r.y & 0xffff0000u);
    f[4] = __uint_as_float(r.z << 16); f[5] = __uint_as_float(r.z & 0xffff0000u); f[6] = __uint_as_float(r.w << 16); f[7] = __uint_as_float(r.w & 0xffff0000u);
}
__device__ __forceinline__ bf16x8 pack8(const float (&f)[8]) {
    u32x4 w; w.x = cvt_pk_op(f[0], f[1]); w.y = cvt_pk_op(f[2], f[3]); w.z = cvt_pk_op(f[4], f[5]); w.w = cvt_pk_op(f[6], f[7]);
    return __builtin_bit_cast(bf16x8, w);
}

__device__ __forceinline__ int lds_byte(int r, int c) { const int st = (r >> 4) * 2 + (c >> 5), rr = r & 15, cc = c & 31, ob = rr * 64 + cc * 2; return st * 1024 + (ob ^ (((ob >> 9) & 1) << 5)); }
__device__ __forceinline__ void stage_rc(int b, int& R, int& C) { const int st = b / 1024, sb = b % 1024, swz = sb ^ (((sb >> 9) & 1) << 5); R = (st >> 1) * 16 + swz / 64; C = (st & 1) * 32 + (swz % 64) / 2; }
__device__ __forceinline__ int perm32(int rho) { const int n = rho >> 4, i = rho & 15; return 8 * (i >> 2) + 4 * n + (i & 3); }

__device__ __forceinline__ int tid_of(int swave) { int l; asm volatile("v_mbcnt_lo_u32_b32 %0, -1, 0\n\tv_mbcnt_hi_u32_b32 %0, -1, %0" : "=v"(l)); return swave * 64 + l; }
struct Unit { const char* A; const char* B0; const char* B1; const int* rows; const int* rtok; int pm, pn, aux, nvalid, half; };

struct Args {
    const float* in[20]; float* out; unsigned char* ws; int ph_lo, ph_hi;
};
enum { I_X = 0, I_RELB, I_NMIXG, I_WIN, I_QG, I_KG, I_SINK, I_CONVW, I_CONVB, I_GATEB, I_MNORMG, I_WOUT, I_NFFNG, I_WRG, I_BRG, I_WRE, I_BRE, I_WGATE, I_WUP, I_WDOWN };


template <class Epi, class Sched, bool MOE>
__device__ __forceinline__ void gemm_phase(LAS unsigned char* lds, const int lda, const int ldb, const int nt, const Sched& S, const Epi& E, const int swave) {
    int tid = tid_of(swave); asm volatile("" : "+v"(tid));
    const int wid = __builtin_amdgcn_readfirstlane(tid >> 6), lane = tid & 63, wr = wid >> 2, wc = wid & 3, fr = lane & 15, fq = lane >> 4;
    int Rr[2], Cc[2]; unsigned voffB[2], voffBd[2];
#pragma unroll
    for (int i = 0; i < 2; ++i) { int R, C; stage_rc(tid * 16 + i * 8192, R, C); Rr[i] = R; Cc[i] = C; const int Rb = (R & ~31) + perm32(R & 31); voffB[i] = (unsigned)(Rb * ldb + C) * 2u; voffBd[i] = (unsigned)(Rb * 512 + C) * 2u; }
    const size_t kstep = (size_t)(BK * 2);
    const size_t hstepB = (size_t)HALF * ldb * 2, hstepBd = (size_t)HALF * 512 * 2;
    const unsigned ldsw = (unsigned)wid * 1024u;
    const int aoff = lds_byte(wr * 64 + fr, fq * 8), boff = lds_byte(wc * 32 + fr, fq * 8);
#define FK_SA(b, h) (((b) * 2 + (h)) * HTB)
#define FK_SB(b, h) ((4 + (b) * 2 + (h)) * HTB)
#define FK_STAGE(bufoff, gbase, voff) do { _Pragma("unroll") for (int _i = 0; _i < 2; ++_i) \
        __builtin_amdgcn_global_load_lds((const unsigned*)((const char*)(gbase) + (voff)[_i]), (LAS unsigned*)(lds + (bufoff) + ldsw + _i * 8192), 16, 0, 0); } while (0)
#define FK_LDA(dst, b, h) do { _Pragma("unroll") for (int m = 0; m < 4; ++m) _Pragma("unroll") for (int k = 0; k < 2; ++k) dst[m][k] = *(const LAS bf16x8*)(lds + FK_SA(b, h) + aoff + m * 2048 + k * 1024); } while (0)
#define FK_LDB(dst, b, h) do { _Pragma("unroll") for (int n = 0; n < 2; ++n) _Pragma("unroll") for (int k = 0; k < 2; ++k) dst[n][k] = *(const LAS bf16x8*)(lds + FK_SB(b, h) + boff + n * 2048 + k * 1024); } while (0)
#define FK_MMA(ai, bj, At, Bt) do { __builtin_amdgcn_s_setprio(1); _Pragma("unroll") for (int m = 0; m < 4; ++m) _Pragma("unroll") for (int n = 0; n < 2; ++n) _Pragma("unroll") for (int k = 0; k < 2; ++k) \
        acc[ai][bj][m][n] = __builtin_amdgcn_mfma_f32_16x16x32_bf16(Bt[n][k], At[m][k], acc[ai][bj][m][n], 0, 0, 0); __builtin_amdgcn_s_setprio(0); } while (0)
#define FK_WAIT_V(n) asm volatile("s_waitcnt vmcnt(" #n ")" ::: "memory")
#define FK_WAIT_L(n) asm volatile("s_waitcnt lgkmcnt(" #n ")" ::: "memory")
#define FK_BAR __builtin_amdgcn_s_barrier()
#define FK_SCHED __builtin_amdgcn_sched_barrier(0)
#define FK_VOFF(u, v) do { _Pragma("unroll") for (int _h = 0; _h < 2; ++_h) _Pragma("unroll") for (int _i = 0; _i < 2; ++_i) { \
        const int _rr = _h * HALF + Rr[_i]; int _row = _rr; \
        if constexpr (MOE) { if ((u).rows) { const int _rc = _rr < (u).nvalid ? _rr : (u).nvalid - 1; _row = __builtin_nontemporal_load((u).rows + _rc); } }     \
        v[_h][_i] = (unsigned)(_row * lda + Cc[_i]) * 2u; \
        asm volatile("" : "+v"(v[_h][_i])); } } while (0)
    Unit cur, nxt; int ui = 0; int pend = -1;
    if (!S.next(0, cur)) return;
    f32x4 acc[2][2][4][2];
#pragma unroll
    for (int a = 0; a < 2; ++a)
#pragma unroll
        for (int b = 0; b < 2; ++b)
#pragma unroll
            for (int m = 0; m < 4; ++m)
#pragma unroll
                for (int n = 0; n < 2; ++n) acc[a][b][m][n] = (f32x4){0.f, 0.f, 0.f, 0.f};
    bf16x8 At[4][2], B0[2][2], B1[2][2];
    unsigned vC[2][2], vN[2][2], vbC[2], vbN[2]; int rawN[2][2];
    size_t hsC = hstepB, hsN = hstepB;
#pragma unroll
    for (int i = 0; i < 2; ++i) { vbC[i] = voffB[i]; vbN[i] = voffB[i]; }
    if constexpr (MOE) { if (cur.aux) { vbC[0] = voffBd[0]; vbC[1] = voffBd[1]; hsC = hstepBd; } }
    FK_VOFF(cur, vC);
    const char* cA = cur.A;
    LAS float* misc = (LAS float*)(lds + MISC_OFF);
    E.prep_all(S, misc, tid);
    S.a_ready(cur, wid, lane);
    FK_STAGE(FK_SB(0, 0), cur.B0, vbC); FK_STAGE(FK_SB(0, 1), cur.B0 + hsC, vbC); FK_STAGE(FK_SA(0, 0), cA, vC[0]); FK_STAGE(FK_SA(0, 1), cA, vC[1]);
    if (wr == 1) FK_BAR;
    FK_WAIT_V(2); FK_BAR;
    FK_STAGE(FK_SB(1, 0), cur.B0 + kstep, vbC); FK_STAGE(FK_SA(1, 0), cA + kstep, vC[0]); FK_STAGE(FK_SB(1, 1), cur.B0 + hsC + kstep, vbC);
    FK_WAIT_V(6); FK_BAR;
    for (;;) {
        const bool has_next = S.next(ui + 1, nxt);
        if constexpr (MOE) {
            if (has_next) {
#pragma unroll
                for (int h = 0; h < 2; ++h)
#pragma unroll
                    for (int i = 0; i < 2; ++i) { const int rr = h * HALF + Rr[i]; int row = rr;
                        if (nxt.rows) { const int rc = rr < nxt.nvalid ? rr : nxt.nvalid - 1; row = __builtin_nontemporal_load(nxt.rows + rc); }
                        rawN[h][i] = row; }
                const bool dn = nxt.aux != 0; vbN[0] = dn ? voffBd[0] : voffB[0]; vbN[1] = dn ? voffBd[1] : voffB[1]; hsN = dn ? hstepBd : hstepB;
            } else {
#pragma unroll
                for (int h = 0; h < 2; ++h)
#pragma unroll
                    for (int i = 0; i < 2; ++i) rawN[h][i] = -1;
                vbN[0] = vbC[0]; vbN[1] = vbC[1]; hsN = hsC;
            }
        }
        const char* nA = has_next ? nxt.A : cA; const char* nB = has_next ? nxt.B0 : cur.B0;
        const bool do0 = cur.half != 1, do1 = cur.half != 0;
        for (int t = 0; t < nt; t += 2) {
            const bool last = (t == nt - 2);
            const char* a1 = cA + (size_t)(t + 1) * kstep;
            const char* a2 = last ? nA : cA + (size_t)(t + 2) * kstep;
            const char* bseg = (t + 2 < (nt >> 1)) ? cur.B0 : cur.B1;
            const char* b2 = last ? nB : bseg + (size_t)(t + 2) * kstep;
            const char* a3 = a2 + kstep; const char* b3 = b2 + kstep;
            if (last && has_next) S.a_ready(nxt, wid, lane);
            if constexpr (MOE) { if (last) {
#pragma unroll
                for (int h = 0; h < 2; ++h)
#pragma unroll
                    for (int i = 0; i < 2; ++i) vN[h][i] = rawN[h][i] < 0 ? vC[h][i] : (unsigned)(rawN[h][i] * lda + Cc[i]) * 2u;
            } }
            unsigned va2[2][2], vb2[2]; size_t hs2 = hsC;
#pragma unroll
            for (int h = 0; h < 2; ++h)
#pragma unroll
                for (int i = 0; i < 2; ++i) { if constexpr (MOE) va2[h][i] = last ? vN[h][i] : vC[h][i]; else va2[h][i] = vC[h][i]; }
#pragma unroll
            for (int i = 0; i < 2; ++i) { if constexpr (MOE) vb2[i] = last ? vbN[i] : vbC[i]; else vb2[i] = vbC[i]; }
            if constexpr (MOE) hs2 = last ? hsN : hsC;
            FK_LDB(B0, 0, 0); FK_LDB(B1, 0, 1); FK_SCHED; FK_LDA(At, 0, 0); FK_STAGE(FK_SA(1, 1), a1, vC[1]);
            FK_WAIT_V(8); FK_WAIT_L(0); FK_BAR; if (do0) { FK_MMA(0, 0, At, B0); FK_MMA(0, 1, At, B1); } FK_BAR; FK_SCHED;
            FK_LDA(At, 0, 1); FK_STAGE(FK_SB(0, 0), b2, vb2); FK_STAGE(FK_SB(0, 1), b2 + hs2, vb2); FK_STAGE(FK_SA(0, 0), a2, va2[0]);
            FK_WAIT_V(8);
            if constexpr (MOE) { if (pend >= 0) { E.publish(pend, lane); pend = -1; } }
            FK_WAIT_L(0); FK_BAR; if (do1) { FK_MMA(1, 0, At, B0); FK_MMA(1, 1, At, B1); } FK_BAR; FK_SCHED;
            FK_LDB(B0, 1, 0); FK_LDB(B1, 1, 1); FK_SCHED; FK_LDA(At, 1, 0); FK_STAGE(FK_SA(0, 1), a2, va2[1]);
            FK_WAIT_V(8); FK_WAIT_L(0); FK_BAR; if (do0) { FK_MMA(0, 0, At, B0); FK_MMA(0, 1, At, B1); } FK_BAR; FK_SCHED;
            FK_LDA(At, 1, 1); FK_STAGE(FK_SB(1, 0), b3, vb2); FK_STAGE(FK_SB(1, 1), b3 + hs2, vb2); FK_STAGE(FK_SA(1, 0), a3, va2[0]);
            FK_WAIT_V(8); FK_WAIT_L(0); FK_BAR; if (do1) { FK_MMA(1, 0, At, B0); FK_MMA(1, 1, At, B1); } FK_BAR; FK_SCHED;
        }
        if (wr == 0) FK_BAR;
        { int fr_ = fr, fq_ = fq; asm volatile("" : "+v"(fr_), "+v"(fq_)); if constexpr (MOE) pend = E(acc, cur, ui, misc, wr, wc, fr_, fq_); else E(acc, cur, ui, misc, wr, wc, fr_, fq_); }
        if (!has_next) break;
#pragma unroll
        for (int a = 0; a < 2; ++a)
#pragma unroll
            for (int b = 0; b < 2; ++b)
#pragma unroll
                for (int m = 0; m < 4; ++m)
#pragma unroll
                    for (int n = 0; n < 2; ++n) acc[a][b][m][n] = (f32x4){0.f, 0.f, 0.f, 0.f};
        cur = nxt; cA = nA; ++ui;
        if constexpr (MOE) {
#pragma unroll
            for (int h = 0; h < 2; ++h)
#pragma unroll
                for (int i = 0; i < 2; ++i) vC[h][i] = vN[h][i];
            vbC[0] = vbN[0]; vbC[1] = vbN[1]; hsC = hsN;
        }
        if (wr == 1) FK_BAR;
    }
    FK_WAIT_V(0);
    if constexpr (MOE) { if (pend >= 0) E.publish(pend, lane); }
    FK_BAR;
#undef FK_SA
#undef FK_SB
#undef FK_STAGE
#undef FK_LDA
#undef FK_LDB
#undef FK_MMA
#undef FK_WAIT_V
#undef FK_WAIT_L
#undef FK_BAR
#undef FK_SCHED
#undef FK_VOFF
}

__device__ __forceinline__ bool deal_item(int i, int n, int G, int c, bool split, int& L, int& half) {
    const int rounds = n / G, tail = n - rounds * G;
    half = -1;
    if (i < rounds) { L = i * G + c; return true; }
    if (i > rounds || tail == 0) return false;
    if (split && 2 * tail <= G) { if (c >= 2 * tail) return false; L = rounds * G + (c >> 1); half = c & 1; return true; }
    if (c >= tail) return false;
    L = rounds * G + c; return true;
}
struct DenseOrder {
    int nM, nN, nwg, G, c; const char* A; const char* Bt; size_t tstepA, tstepB;
    __device__ void init(int M, int N, int G_, int c_, const void* A_, int lda, const void* Bt_, int ldb) { nM = M / BM; nN = N / BM; nwg = nM * nN; G = G_; c = c_; A = (const char*)A_; Bt = (const char*)Bt_; tstepA = (size_t)BM * lda * 2; tstepB = (size_t)BM * ldb * 2; }
    __device__ __forceinline__ bool next(int i, Unit& u) const {
        int L, half; if (!deal_item(i, nwg, G, c, false, L, half)) return false;
        int wgid = L; { const int q = nwg / 8, r = nwg % 8, xcd = wgid % 8, off = wgid / 8; wgid = (xcd < r ? xcd * (q + 1) : r * (q + 1) + (xcd - r) * q) + off; }
        const int nig = 8 * nN, gid = wgid / nig, fm = gid * 8, gsz = (nM - fm) < 8 ? (nM - fm) : 8;
        u.pm = fm + ((wgid % nig) % gsz); u.pn = (wgid % nig) / gsz;
        u.A = A + (size_t)u.pm * tstepA; u.B0 = Bt + (size_t)u.pn * tstepB; u.B1 = u.B0; u.rows = nullptr; u.rtok = nullptr; u.aux = 0; u.nvalid = BM; u.half = half; return true;
    }
    __device__ __forceinline__ void a_ready(const Unit&, int, int) const {}
};

struct EpiInProj {
    const float* ssq; bf16_t* proj; float* gates; const float* gate_b;
    template <class Sched> __device__ __forceinline__ void prep_all(const Sched& S, LAS float* misc, int tid) const {
        const int r = tid >> 1; f32x4 s0[4], s1[4]; bool have[4];
#pragma unroll
        for (int i = 0; i < 4; ++i) { Unit u; have[i] = S.next(i, u); const int pm = have[i] ? u.pm : 0;
            const f32x4* sp = (const f32x4*)(ssq + (size_t)(pm * BM + r) * 16 + (tid & 1) * 8); s0[i] = sp[0]; s1[i] = sp[1]; }
#pragma unroll
        for (int i = 0; i < 4; ++i) {
            float ss = ((s0[i][0] + s0[i][1]) + (s0[i][2] + s0[i][3])) + ((s1[i][0] + s1[i][1]) + (s1[i][2] + s1[i][3]));
            ss += __shfl_xor(ss, 1);
            if (have[i] && (tid & 1) == 0) misc[i * 256 + r] = rsqrtf(ss * (1.f / 1024.f) + 1e-6f);
        }
    }
    __device__ __forceinline__ void prep(const Unit&, int, LAS float*, int) const {}
    __device__ __forceinline__ void operator()(const f32x4 (&acc)[2][2][4][2], const Unit& u, int ui, const LAS float* misc, int wr, int wc, int fr, int fq) const {
        const int rl0 = wr * 64 + fr, row0 = u.pm * BM + rl0;
        const LAS float* tab = misc + ui * 256;
#pragma unroll
        for (int ai = 0; ai < 2; ++ai)
#pragma unroll
            for (int m = 0; m < 4; ++m) {
                if (u.half >= 0 && u.half != ai) continue;
                const int row = row0 + ai * HALF + m * 16;
                const float rs = tab[rl0 + ai * HALF + m * 16];
                if (u.pn < 9) {
                    bf16_t* rowp = proj + (size_t)row * NPROJ + u.pn * BM + wc * 32 + 8 * fq;
#pragma unroll
                    for (int bj = 0; bj < 2; ++bj) { const f32x4 v0 = acc[ai][bj][m][0] * rs, v1 = acc[ai][bj][m][1] * rs;
                        u32x4 w; w.x = cvt_pk_bf16(v0[0], v0[1]); w.y = cvt_pk_bf16(v0[2], v0[3]); w.z = cvt_pk_bf16(v1[0], v1[1]); w.w = cvt_pk_bf16(v1[2], v1[3]);
                        *(u32x4*)(rowp + bj * HALF) = w; }
                } else if (wc == 0 && fq == 0) {
                    const f32x4 g0 = *(const f32x4*)(gate_b), g1 = *(const f32x4*)(gate_b + 4);
                    *(f32x4*)(gates + (size_t)row * 8) = acc[ai][0][m][0] * rs + g0;
                    *(f32x4*)(gates + (size_t)row * 8 + 4) = acc[ai][0][m][1] * rs + g1;
                }
            }
    }
};


template <bool INDIRECT, bool FINAL>
struct EpiResid {
    bf16_t* xb; float* out; float* ssq;
    template <class Sched> __device__ __forceinline__ void prep_all(const Sched&, LAS float*, int) const {}
    __device__ __forceinline__ void prep(const Unit&, int, LAS float*, int) const {}
    __device__ __forceinline__ void operator()(const f32x4 (&acc)[2][2][4][2], const Unit& u, int ui, const LAS float* misc, int wr, int wc, int fr, int fq) const {
        const int col0 = u.pn * BM + wc * 32 + 8 * fq;
        int tok[2][4];
#pragma unroll
        for (int ai = 0; ai < 2; ++ai)
#pragma unroll
            for (int m = 0; m < 4; ++m) { const int rl = ai * HALF + wr * 64 + m * 16 + fr; if constexpr (INDIRECT) { const int t_ = __builtin_nontemporal_load(u.rtok + (rl < u.nvalid ? rl : u.nvalid - 1)); tok[ai][m] = rl < u.nvalid ? t_ : -1; } else tok[ai][m] = u.pm * BM + rl; }
#pragma unroll
        for (int ai = 0; ai < 2; ++ai) {
            if (u.half >= 0 && u.half != ai) continue;
            u32x4 xr[4][2];
#pragma unroll
            for (int m = 0; m < 4; ++m)
#pragma unroll
                for (int bj = 0; bj < 2; ++bj) { const int tk = tok[ai][m] < 0 ? 0 : tok[ai][m]; xr[m][bj] = *(const u32x4*)(xb + (size_t)tk * D + col0 + bj * HALF); }
#pragma unroll
            for (int m = 0; m < 4; ++m) {
                const int tk = tok[ai][m];
                if (tk >= 0) {
                    const size_t off = (size_t)tk * D + col0;
                    float part = 0.f;
#pragma unroll
                    for (int bj = 0; bj < 2; ++bj) {
                        float x[8]; unpack8(xr[m][bj], x);
                        float h[8];
#pragma unroll
                        for (int j = 0; j < 4; ++j) { h[j] = x[j] + acc[ai][bj][m][0][j]; h[4 + j] = x[4 + j] + acc[ai][bj][m][1][j]; }
#pragma unroll
                        for (int j = 0; j < 8; ++j) part += h[j] * h[j];
                        if constexpr (FINAL) { *(f32x4*)(out + off + bj * HALF) = (f32x4){h[0], h[1], h[2], h[3]}; *(f32x4*)(out + off + bj * HALF + 4) = (f32x4){h[4], h[5], h[6], h[7]}; }
                        else { u32x4 w; w.x = cvt_pk_bf16(h[0], h[1]); w.y = cvt_pk_bf16(h[2], h[3]); w.z = cvt_pk_bf16(h[4], h[5]); w.w = cvt_pk_bf16(h[6], h[7]); *(u32x4*)(xb + off + bj * HALF) = w; }
                    }
                    if constexpr (!FINAL) {
                        part += __shfl_xor(part, 16); part += __shfl_xor(part, 32);
                        if (fq == 0) ssq[(size_t)tk * 16 + u.pn * 4 + wc] = part;
                    }
                }
            }
        }
    }
};

__device__ __forceinline__ void store16_sc1(void* p, u32x4 v) { asm volatile("global_store_dwordx4 %0, %1, off sc1\n\ts_nop 1" :: "v"(p), "v"(v) : "memory"); }
struct EpiUp {
    bf16_t* act; const float* rw; unsigned* upcnt;
    __device__ __forceinline__ void operator()(const f32x4 (&acc)[2][2][4][2], const Unit& u, int wr, int wc, int fr, int fq) const {
        const int slot = u.pn >> 2, col0 = slot * 512 + (u.pn & 3) * 128 + wc * 32 + 8 * fq;
        int tok[2][4];
#pragma unroll
        for (int ai = 0; ai < 2; ++ai)
#pragma unroll
            for (int m = 0; m < 4; ++m) { const int rl = ai * HALF + wr * 64 + m * 16 + fr; const int t_ = __builtin_nontemporal_load(u.rtok + (rl < u.nvalid ? rl : u.nvalid - 1)); tok[ai][m] = rl < u.nvalid ? t_ : -1; }
        f32x4 wv[2][4];
#pragma unroll
        for (int ai = 0; ai < 2; ++ai)
#pragma unroll
            for (int m = 0; m < 4; ++m) { const f32x4 w_ = __builtin_nontemporal_load((const f32x4*)(rw + (size_t)(tok[ai][m] < 0 ? 0 : tok[ai][m]) * 4)); wv[ai][m] = tok[ai][m] >= 0 ? w_ : (f32x4){0.f, 0.f, 0.f, 0.f}; }
#pragma unroll
        for (int ai = 0; ai < 2; ++ai)
#pragma unroll
            for (int m = 0; m < 4; ++m) {
                if (u.half >= 0 && u.half != ai) continue;
                const int rl = ai * HALF + wr * 64 + m * 16 + fr;
                const float rs = wv[ai][m][2], ws_ = (slot ? wv[ai][m][1] : wv[ai][m][0]) * rs;
                float o[8];
#pragma unroll
                for (int n = 0; n < 2; ++n)
#pragma unroll
                    for (int j = 0; j < 4; ++j) { const float gv = acc[ai][0][m][n][j] * rs, uv = acc[ai][1][m][n][j]; o[n * 4 + j] = gv * __builtin_amdgcn_rcpf(1.f + __expf(-gv)) * uv * ws_; }
                u32x4 pk; pk.x = cvt_pk_bf16(o[0], o[1]); pk.y = cvt_pk_bf16(o[2], o[3]); pk.z = cvt_pk_bf16(o[4], o[5]); pk.w = cvt_pk_bf16(o[6], o[7]);
                store16_sc1(act + ((size_t)u.pm * BM + rl) * 1024 + col0, pk);
            }
    }
    __device__ __forceinline__ void publish(int pend, int lane) const { if (lane == 0) __hip_atomic_fetch_add(upcnt + (pend >> 2), (unsigned)(pend & 3), __ATOMIC_RELAXED, __HIP_MEMORY_SCOPE_AGENT); }
};
template <bool FINAL>
struct EpiMoe {
    EpiUp up; EpiResid<true, FINAL> dn;
    template <class Sched> __device__ __forceinline__ void prep_all(const Sched&, LAS float*, int) const {}
    __device__ __forceinline__ void prep(const Unit&, int, LAS float*, int) const {}
    __device__ __forceinline__ int operator()(const f32x4 (&acc)[2][2][4][2], const Unit& u, int ui, const LAS float* misc, int wr, int wc, int fr, int fq) const {
        if (u.aux == 0) {
            up(acc, u, wr, wc, fr, fq);
            asm volatile("s_waitcnt vmcnt(0)" ::: "memory");
            up.publish(u.pm * 4 + (u.half < 0 ? 2 : 1), fq * 16 + fr);
            return -1;
        }
        dn(acc, u, ui, misc, wr, wc, fr, fq); return -1;
    }
    __device__ __forceinline__ void publish(int tile, int lane) const { up.publish(tile, lane); }
};

__device__ __forceinline__ int ld_ctl(const int* p) { return (int)__hip_atomic_load((const unsigned*)p, __ATOMIC_RELAXED, __HIP_MEMORY_SCOPE_AGENT); }
__device__ __forceinline__ void pair_dec(int p, int& lo, int& hi) { lo = (p < 3) ? 0 : ((p < 5) ? 1 : 2); hi = (p < 3) ? p + 1 : ((p < 5) ? p - 1 : 3); }

struct MoeOrder {
    int ntile, G, c, nup8, ndn4;
    int pad_;
    const LAS int* tb; const int* rowtokb; const char* xb; const char* wgu; const char* act; const char* wd; unsigned* upcnt;
    __device__ __forceinline__ bool next(int i, Unit& u) const {
        int L, half = -1; const int kind = nup8 ? 0 : 1;
        if (kind == 0) { if (!deal_item(i, nup8 * 8, G, c, pad_ != 0, L, half)) return false; }
        else {
            const int nd = ndn4 * 4, rup = (ntile * 8) % G, nlight = G - rup; const bool heavy = c < rup;
            int tl = 0, th = 3, base = 0, mine = 0; L = -1;
            for (int r = 0; r < 1024 && base < nd; ++r) {
                const bool toheavy = (rup > 0) && (th + 2 < tl + 2);
                const int gsz = toheavy ? rup : nlight, gidx = toheavy ? c : c - rup;
                if (toheavy == heavy) { if (mine == i) { L = base + gidx; break; } ++mine; }
                if (toheavy) th += 2; else tl += 2;
                base += gsz;
            }
            if (L < 0 || L >= nd) return false;
        }
        const int mt = kind ? (L >> 2) : (L >> 3), pn = kind ? (L & 3) : (L & 7);
        int b = 0;
        for (int j = 1; j < 24; ++j) if (__builtin_amdgcn_readfirstlane(tb[j]) <= mt) b = j;
        const int jl = mt - __builtin_amdgcn_readfirstlane(tb[b]); const int left = __builtin_amdgcn_readfirstlane(tb[32 + b]) - jl * 256;
        const int grp = b / 6; int lo, hi; pair_dec(b % 6, lo, hi);
        u.pm = mt; u.pn = pn; u.aux = kind; u.nvalid = left < 256 ? left : 256; u.half = half;
        u.rtok = rowtokb + (size_t)b * T + jl * 256;
        if (kind == 0) { const int e = grp * 4 + ((pn >> 2) ? hi : lo);
            u.A = xb; u.rows = u.rtok; u.B0 = wgu + ((size_t)e * 1024 + (pn & 3) * 256) * 2048; u.B1 = u.B0; }
        else { u.A = act + (size_t)mt * BM * 2048; u.rows = nullptr;
            u.B0 = wd + ((size_t)(grp * 4 + lo) * 1024 + pn * 256) * 1024; u.B1 = wd + ((size_t)(grp * 4 + hi) * 1024 + pn * 256) * 1024 - 8 * 128; }
        return true;
    }
    __device__ __forceinline__ void a_ready(const Unit& u, int wid, int lane) const {
        if (u.aux != 0) {
            if (wid == 0) {
                unsigned spins = 0;
                while ((unsigned)__builtin_amdgcn_readfirstlane(__hip_atomic_load(upcnt + u.pm, __ATOMIC_RELAXED, __HIP_MEMORY_SCOPE_AGENT)) < 128u) { __builtin_amdgcn_s_sleep(2); if (++spins > (1u << 22)) break; }
                __builtin_amdgcn_fence(__ATOMIC_ACQUIRE, "agent");
                asm volatile("s_waitcnt vmcnt(0)" ::: "memory");
            }
            asm volatile("" ::: "memory"); __builtin_amdgcn_s_barrier(); asm volatile("" ::: "memory");
        }
    }
};

constexpr int RT_PITCH = 2064;
__device__ __forceinline__ void route1_phase(const Args& a, int l, LAS unsigned char* lds, int bx, int G, int tid) {
    unsigned char* ws = a.ws;
    const int wave = tid >> 6, lane = tid & 63;
    LAS unsigned char* Wt = lds; LAS float* red = (LAS float*)(lds + 48 * RT_PITCH);
    { const u32x4* rt = (const u32x4*)(ws + FW_RT + (size_t)l * 48 * 2048);
      for (int idx = tid; idx < 48 * 128; idx += NTHR) { const int r = idx >> 7, c16 = idx & 127; *(LAS u32x4*)(Wt + r * RT_PITCH + c16 * 16) = __builtin_nontemporal_load(rt + idx); } }
    __syncthreads();
    const bf16_t* hg = (const bf16_t*)(ws + FW_XG); const float* ssq = (const float*)(ws + FW_SSQ);
    float* RW = (float*)(ws + FW_RW); int* ROWTOKB = (int*)(ws + FW_ROWTOKB); unsigned* BCNT = (unsigned*)(ws + FW_CTL) + CW_BCNT + 64 * l;
    for (int slab = bx; slab < 256; slab += G) {
        const int mb = wave & 3, kh = wave >> 2, fr = lane & 15, fq = lane >> 4;
        f32x4 acc[3];
#pragma unroll
        for (int nb = 0; nb < 3; ++nb) acc[nb] = (f32x4){0.f, 0.f, 0.f, 0.f};
        const bf16_t* arow = hg + (size_t)(slab * 64 + mb * 16 + fr) * D + kh * 512 + fq * 8;
        bf16x8 afr[16];
#pragma unroll
        for (int ks = 0; ks < 16; ++ks) afr[ks] = *(const bf16x8*)(arow + ks * 32);
#pragma unroll
        for (int ks = 0; ks < 16; ++ks) {
            const bf16x8 af = afr[ks];
#pragma unroll
            for (int nb = 0; nb < 3; ++nb) {
                const bf16x8 bf = *(const LAS bf16x8*)(Wt + (nb * 16 + fr) * RT_PITCH + (kh * 512 + ks * 32 + fq * 8) * 2);
                acc[nb] = __builtin_amdgcn_mfma_f32_16x16x32_bf16(af, bf, acc[nb], 0, 0, 0);
            }
        }
#pragma unroll
        for (int nb = 0; nb < 3; ++nb)
#pragma unroll
            for (int r = 0; r < 4; ++r) red[(kh * 64 + mb * 16 + fq * 4 + r) * 48 + nb * 16 + fr] = acc[nb][r];
        __syncthreads();
        if (tid < 64) {
            const int t = slab * 64 + tid;
            float lg[20];
#pragma unroll
            for (int j = 0; j < 20; ++j) lg[j] = (red[tid * 48 + j] + red[(64 + tid) * 48 + j]) + (red[tid * 48 + 24 + j] + red[(64 + tid) * 48 + 24 + j]);
            float ss = 0.f;
#pragma unroll
            for (int i = 0; i < 16; ++i) ss += ssq[(size_t)t * 16 + i];
            const float rs = rsqrtf(ss * (1.f / 1024.f) + 1e-6f);
            const float* brg = a.in[I_BRG] + l * 4; const float* bre = a.in[I_BRE] + l * 16;
            float gl[4]; int grp = 0;
#pragma unroll
            for (int j = 0; j < 4; ++j) gl[j] = lg[j] * rs + brg[j];
#pragma unroll
            for (int j = 1; j < 4; ++j) if (gl[j] > gl[grp]) grp = j;
            float gs = 0.f;
#pragma unroll
            for (int j = 0; j < 4; ++j) gs += __expf(gl[j] - gl[grp]);
            const float pg = 1.f / gs;
            float el[4];
#pragma unroll
            for (int j = 0; j < 4; ++j) { float v = 0.f;
#pragma unroll
                for (int q = 0; q < 4; ++q) if (q == grp) v = lg[4 + q * 4 + j] * rs + bre[q * 4 + j];
                el[j] = v; }
            int i0 = 0;
#pragma unroll
            for (int j = 1; j < 4; ++j) if (el[j] > el[i0]) i0 = j;
            int i1 = (i0 == 0) ? 1 : 0;
#pragma unroll
            for (int j = 0; j < 4; ++j) if (j != i0 && el[j] > el[i1]) i1 = j;
            const float w0 = 1.f / (1.f + __expf(el[i1] - el[i0])), w1 = 1.f - w0;
            const int plo = i0 < i1 ? i0 : i1, phi = i0 < i1 ? i1 : i0;
            const float wlo = (i0 < i1 ? w0 : w1) * pg, whi = (i0 < i1 ? w1 : w0) * pg;
            const int pidx = (plo == 0) ? (phi - 1) : ((plo == 1) ? (phi + 1) : 5);
            const int bk = grp * 6 + pidx;
            *(f32x4*)(RW + t * 4) = (f32x4){wlo, whi, rs, 0.f};
            int lpos = 0; unsigned mycnt = 0;
#pragma unroll 1
            for (int b = 0; b < 24; ++b) {
                const unsigned long long mk = __ballot(bk == b);
                if (bk == b) lpos = __popcll(mk & ((1ull << lane) - 1ull));
                if (lane == b) mycnt = (unsigned)__popcll(mk);
            }
            unsigned base = 0;
            if (mycnt > 0) base = __hip_atomic_fetch_add(BCNT + lane, mycnt, __ATOMIC_RELAXED, __HIP_MEMORY_SCOPE_AGENT);
            const int pos = (int)__shfl(base, bk) + lpos;
            ROWTOKB[(size_t)bk * T + pos] = t;
        }
        __syncthreads();
    }
}
__device__ __forceinline__ float ld_f(const float* p) { return __hip_atomic_load(p, __ATOMIC_RELAXED, __HIP_MEMORY_SCOPE_AGENT); }
__device__ __forceinline__ float scan_add(float v, int lane) {
#pragma unroll
    for (int o = 1; o < 64; o <<= 1) { const float y = __int_as_float(__builtin_amdgcn_ds_bpermute(((lane - o) & 63) << 2, __float_as_int(v))); if (lane >= o) v += y; }
    return v;
}
__device__ __forceinline__ float scan_max(float v, int lane) {
#pragma unroll
    for (int o = 1; o < 64; o <<= 1) { const float y = __int_as_float(__builtin_amdgcn_ds_bpermute(((lane - o) & 63) << 2, __float_as_int(v))); if (lane >= o) v = fmaxf(v, y); }
    return v;
}
__device__ __forceinline__ float logsigf(float x) { return fminf(x, 0.f) - log1pf(__expf(-fabsf(x))); }
__device__ __forceinline__ void conv8(const bf16_t* proj, size_t tok, int tpos, const float* cw, const float* cb, int ch, float (&y)[8]) {
    const f32x4 b0 = *(const f32x4*)(cb + ch), b1 = *(const f32x4*)(cb + ch + 4);
#pragma unroll
    for (int j = 0; j < 4; ++j) { y[j] = b0[j]; y[4 + j] = b1[j]; }
#pragma unroll
    for (int j = 0; j < 4; ++j) {
        const int dt = 3 - j;
        if (tpos - dt >= 0) {
            const u32x4 r = *(const u32x4*)(proj + (tok - dt) * NPROJ + 768 + ch);
            float x[8]; unpack8(r, x);
            const f32x4 w0 = *(const f32x4*)(cw + j * 512 + ch), w1 = *(const f32x4*)(cw + j * 512 + ch + 4);
#pragma unroll
            for (int i = 0; i < 4; ++i) { y[i] += w0[i] * x[i]; y[4 + i] += w1[i] * x[4 + i]; }
        }
    }
#pragma unroll
    for (int i = 0; i < 8; ++i) y[i] = y[i] * __builtin_amdgcn_rcpf(1.f + __expf(-y[i]));
}


__device__ __forceinline__ void conv32(const bf16_t* proj, size_t tok, int tpos, const float* cw, const float* cb, int ch, float (&y)[32]) {
    u32x4 r[4][4];
#pragma unroll
    for (int j = 0; j < 4; ++j) {
        const int dt = 3 - j;
#pragma unroll
        for (int i = 0; i < 4; ++i) r[j][i] = (tpos - dt >= 0) ? *(const u32x4*)(proj + (tok - dt) * NPROJ + 768 + ch + i * 8) : (u32x4){0u, 0u, 0u, 0u};
    }
#pragma unroll
    for (int i = 0; i < 8; ++i) { const f32x4 b4 = *(const f32x4*)(cb + ch + i * 4);
#pragma unroll
        for (int e = 0; e < 4; ++e) y[i * 4 + e] = b4[e]; }
#pragma unroll
    for (int j = 0; j < 4; ++j)
#pragma unroll
        for (int i = 0; i < 4; ++i) {
            float x[8]; unpack8(r[j][i], x);
            const f32x4 w0 = *(const f32x4*)(cw + j * 512 + ch + i * 8), w1 = *(const f32x4*)(cw + j * 512 + ch + i * 8 + 4);
#pragma unroll
            for (int e = 0; e < 4; ++e) { y[i * 8 + e] += w0[e] * x[e]; y[i * 8 + 4 + e] += w1[e] * x[4 + e]; }
        }
#pragma unroll
    for (int i = 0; i < 32; ++i) y[i] = y[i] * __builtin_amdgcn_rcpf(1.f + __expf(-y[i]));
}

constexpr int KS_PITCH = 144, VT_PITCH = 528;
constexpr int AT_KS = 0, AT_VT = 256 * KS_PITCH, AT_BT = AT_VT + 64 * VT_PITCH;
__device__ __forceinline__ void attn_unit(const Args& a, const int l, LAS unsigned char* lds, const int unit, const int tid) {
    const bf16_t* proj = (const bf16_t*)(a.ws + FW_PROJ); bf16_t* mix = (bf16_t*)(a.ws + FW_MIX);
    const int wave = tid >> 6, lane = tid & 63, c = lane & 15, q = lane >> 4;
    const int b = unit >> 6, n = (unit >> 1) & 31, kvh = unit & 1;
    const size_t tok0 = (size_t)b * SEQ + n * 128;
    const int g = wave >> 1, rh = wave & 1, head = kvh * 4 + g;
    u32x4 qraw[4][2];
#pragma unroll
    for (int i = 0; i < 4; ++i)
#pragma unroll
        for (int ks = 0; ks < 2; ++ks) qraw[i][ks] = *(const u32x4*)(proj + (tok0 + (rh * 4 + i) * 16 + c) * NPROJ + head * 64 + ks * 32 + q * 8);
    {
        const int key = tid >> 1, half = tid & 1;
        const bool valid = (n > 0) || (key >= 128);
        const bf16_t* rowp = proj + (tok0 + key - 128) * NPROJ;
        u32x4 kr[4], vr[4];
#pragma unroll
        for (int i = 0; i < 4; ++i) { kr[i] = (u32x4){0u, 0u, 0u, 0u}; vr[i] = kr[i]; }
        if (valid) {
#pragma unroll
            for (int i = 0; i < 4; ++i) { kr[i] = *(const u32x4*)(rowp + 512 + kvh * 64 + half * 32 + i * 8); vr[i] = *(const u32x4*)(rowp + 640 + kvh * 64 + half * 32 + i * 8); }
        }
        float kf[4][8]; float ss = 0.f;
#pragma unroll
        for (int i = 0; i < 4; ++i) { unpack8(kr[i], kf[i]);
#pragma unroll
            for (int j = 0; j < 8; ++j) ss += kf[i][j] * kf[i][j]; }
        ss += __shfl_xor(ss, 1);
        const float rs = rsqrtf(ss * (1.f / 64.f) + 1e-6f);
        const float* kg = a.in[I_KG] + l * 64 + half * 32;
#pragma unroll
        for (int i = 0; i < 4; ++i) {
#pragma unroll
            for (int j = 0; j < 8; ++j) kf[i][j] *= rs * kg[i * 8 + j];
            *(LAS bf16x8*)(lds + AT_KS + key * KS_PITCH + half * 64 + i * 16) = pack8(kf[i]);
        }
#pragma unroll
        for (int i = 0; i < 4; ++i) {
            const unsigned w4[4] = {vr[i].x, vr[i].y, vr[i].z, vr[i].w};
#pragma unroll
            for (int j = 0; j < 4; ++j) {
                *(LAS bf16_t*)(lds + AT_VT + (half * 32 + i * 8 + 2 * j) * VT_PITCH + key * 2) = (bf16_t)(w4[j] & 0xffffu);
                *(LAS bf16_t*)(lds + AT_VT + (half * 32 + i * 8 + 2 * j + 1) * VT_PITCH + key * 2) = (bf16_t)(w4[j] >> 16);
            }
        }
        const int h4 = tid >> 7, dist = tid & 127;
        LAS float* bt = (LAS float*)(lds + AT_BT) + h4 * 384;
        bt[128 + dist] = a.in[I_RELB][t5_bucket(dist) * 8 + kvh * 4 + h4] * 1.4426950408889634f;
        bt[dist] = -INFINITY; bt[256 + dist] = -INFINITY;
    }
    __syncthreads();
    const float sink = a.in[I_SINK][l * 8 + head] * 1.4426950408889634f;
    const float* qg = a.in[I_QG] + l * 64;
    const LAS float* btab = (const LAS float*)(lds + AT_BT) + g * 384;
#pragma unroll 1
    for (int i = 0; i < 4; ++i) {
        const int tb = rh * 4 + i, tt = tb * 16 + c;
        const size_t tq = tok0 + tt;
        bf16x8 qf[2];
        {
            float qv[2][8]; float ss = 0.f;
#pragma unroll
            for (int ks = 0; ks < 2; ++ks) { unpack8(qraw[0][ks], qv[ks]);
#pragma unroll
                for (int j = 0; j < 8; ++j) ss += qv[ks][j] * qv[ks][j]; }
            ss += __shfl_xor(ss, 16); ss += __shfl_xor(ss, 32);
            const float rs = rsqrtf(ss * (1.f / 64.f) + 1e-6f) * (0.125f * 1.4426950408889634f);
#pragma unroll
            for (int ks = 0; ks < 2; ++ks) {
#pragma unroll
                for (int j = 0; j < 8; ++j) qv[ks][j] *= rs * qg[ks * 32 + q * 8 + j];
                qf[ks] = pack8(qv[ks]); }
#pragma unroll
            for (int j = 0; j < 3; ++j) { qraw[j][0] = qraw[j + 1][0]; qraw[j][1] = qraw[j + 1][1]; }
        }
        const int sb0 = tb & ~1;
        f32x4 acc[10];
#pragma unroll
        for (int x = 0; x < 10; ++x) {
            acc[x] = (f32x4){0.f, 0.f, 0.f, 0.f};
#pragma unroll
            for (int ks = 0; ks < 2; ++ks) { const bf16x8 kf = *(const LAS bf16x8*)(lds + AT_KS + ((sb0 + x) * 16 + c) * KS_PITCH + ks * 64 + q * 16);
                acc[x] = __builtin_amdgcn_mfma_f32_16x16x32_bf16(kf, qf[ks], acc[x], 0, 0, 0); }
        }
        float m = -INFINITY;
        const LAS float* bp = btab + (128 + tt + 128 - sb0 * 16 - 4 * q);
#pragma unroll
        for (int x = 0; x < 10; ++x)
#pragma unroll
            for (int r = 0; r < 4; ++r) { const float lg = acc[x][r] + bp[-(x * 16 + r)]; acc[x][r] = lg; }
        if (n == 0) {
#pragma unroll
            for (int x = 0; x < 10; ++x)
#pragma unroll
                for (int r = 0; r < 4; ++r) { const int kk = (sb0 + x) * 16 + 4 * q + r; if (kk < 128) acc[x][r] = -INFINITY; }
        }
#pragma unroll
        for (int x = 0; x < 10; ++x)
#pragma unroll
            for (int r = 0; r < 4; ++r) m = fmaxf(m, acc[x][r]);
        m = fmaxf(m, __shfl_xor(m, 16)); m = fmaxf(m, __shfl_xor(m, 32)); m = fmaxf(m, sink);
        float sum = 0.f;
#pragma unroll
        for (int x = 0; x < 10; ++x)
#pragma unroll
            for (int r = 0; r < 4; ++r) { const float p = __builtin_amdgcn_exp2f(acc[x][r] - m); acc[x][r] = p; sum += p; }
        sum += __shfl_xor(sum, 16); sum += __shfl_xor(sum, 32);
        const float inv = 1.f / (sum + __builtin_amdgcn_exp2f(sink - m));
        bf16x8 pf[5];
#pragma unroll
        for (int kp = 0; kp < 5; ++kp) { float f[8];
#pragma unroll
            for (int r = 0; r < 4; ++r) { f[r] = acc[2 * kp][r] * inv; f[4 + r] = acc[2 * kp + 1][r] * inv; }
            pf[kp] = pack8(f); }
#pragma unroll
        for (int db = 0; db < 4; ++db) {
            f32x4 o = (f32x4){0.f, 0.f, 0.f, 0.f};
#pragma unroll
            for (int kp = 0; kp < 5; ++kp) {
                const LAS unsigned char* vp = lds + AT_VT + (db * 16 + c) * VT_PITCH + (sb0 * 16 + 32 * kp + 4 * q) * 2;
                const u32x2 lo = *(const LAS u32x2*)vp, hi = *(const LAS u32x2*)(vp + 32);
                const u32x4 vv = (u32x4){lo.x, lo.y, hi.x, hi.y};
                o = __builtin_amdgcn_mfma_f32_16x16x32_bf16(__builtin_bit_cast(bf16x8, vv), pf[kp], o, 0, 0, 0);
            }
            u32x2 w; w.x = cvt_pk_bf16(o[0], o[1]); w.y = cvt_pk_bf16(o[2], o[3]);
            *(u32x2*)(mix + tq * D + head * 64 + db * 16 + 4 * q) = w;
        }
    }
    __syncthreads();
}

constexpr int ML_PITCH = 144;
constexpr int MA_VT = 0, MA_KT = 4 * 128 * ML_PITCH, MA_W = MA_KT + 4 * 64 * ML_PITCH;
__device__ __forceinline__ void stage_vt(const bf16_t* proj, size_t t0, LAS unsigned char* vt, int tid) {
    const int s = tid & 63, vg = tid >> 6;
    const bf16_t* rowp = proj + (t0 + s) * NPROJ + 1280 + vg * 64;
#pragma unroll
    for (int i = 0; i < 8; ++i) {
        const u32x4 r = *(const u32x4*)(rowp + i * 8);
        const unsigned w4[4] = {r.x, r.y, r.z, r.w};
#pragma unroll
        for (int j = 0; j < 4; ++j) {
            *(LAS bf16_t*)(vt + (vg * 64 + i * 8 + 2 * j) * ML_PITCH + s * 2) = (bf16_t)(w4[j] & 0xffffu);
            *(LAS bf16_t*)(vt + (vg * 64 + i * 8 + 2 * j + 1) * ML_PITCH + s * 2) = (bf16_t)(w4[j] >> 16);
        }
    }
}
__device__ __forceinline__ void mlstm_a_unit(const Args& a, const int l, LAS unsigned char* lds, const int unit, const int tid) {
    const bf16_t* proj = (const bf16_t*)(a.ws + FW_PROJ); const float* gates = (const float*)(a.ws + FW_GATES);
    const int wave = tid >> 6, lane = tid & 63, c = lane & 15, q = lane >> 4;
    const int b = unit >> 6, ck = unit & 63;
    const size_t t0 = (size_t)b * SEQ + ck * 64;
    LAS float* wS = (LAS float*)(lds + MA_W);
    if (wave < 4) {
        const int h = wave; const size_t t = t0 + lane;
        const float li = gates[t * 8 + h], lf = logsigf(gates[t * 8 + 4 + h]);
        const float bc = scan_add(lf, lane), blast = __shfl(bc, 63);
        const float logw = blast - bc + li, ac = wave_max(logw);
        wS[h * 64 + lane] = __expf(logw - ac);
        if (lane == 0) { float* sc = (float*)(a.ws + FW_SC) + ((size_t)(b * 4 + h) * 64 + ck) * 2; sc[0] = blast; sc[1] = ac; }
    }
    __syncthreads();
    {
        const int s = tid & 63, cg = tid >> 6, head = cg >> 1;
        const float wv = wS[head * 64 + s] * 0.125f;
        const float* cw = a.in[I_CONVW] + l * 2048; const float* cb = a.in[I_CONVB] + l * 512;
        float y[32];
        conv32(proj, t0 + s, ck * 64 + s, cw, cb, 256 + cg * 32, y);
#pragma unroll
        for (int j = 0; j < 32; ++j) *(LAS bf16_t*)(lds + MA_KT + (cg * 32 + j) * ML_PITCH + s * 2) = f2bf(y[j] * wv);
        stage_vt(proj, t0, lds + MA_VT, tid);
    }
    __syncthreads();
    {
        const int head = wave >> 1, vh = wave & 1, bh = b * 4 + head;
        f32x4 acc[4][4];
#pragma unroll
        for (int db = 0; db < 4; ++db)
#pragma unroll
            for (int vb = 0; vb < 4; ++vb) acc[db][vb] = (f32x4){0.f, 0.f, 0.f, 0.f};
#pragma unroll
        for (int ks = 0; ks < 2; ++ks) {
            bf16x8 vf[4];
#pragma unroll
            for (int vb = 0; vb < 4; ++vb) vf[vb] = *(const LAS bf16x8*)(lds + MA_VT + (head * 128 + vh * 64 + vb * 16 + c) * ML_PITCH + ks * 64 + q * 16);
#pragma unroll
            for (int db = 0; db < 4; ++db) {
                const bf16x8 kf = *(const LAS bf16x8*)(lds + MA_KT + (head * 64 + db * 16 + c) * ML_PITCH + ks * 64 + q * 16);
#pragma unroll
                for (int vb = 0; vb < 4; ++vb) acc[db][vb] = __builtin_amdgcn_mfma_f32_16x16x32_bf16(kf, vf[vb], acc[db][vb], 0, 0, 0);
            }
        }
        bf16_t* U = (bf16_t*)((unsigned char*)a.out + OUT_USTATE) + ((size_t)bh * 64 + ck) * 8192;
#pragma unroll
        for (int db = 0; db < 4; ++db)
#pragma unroll
            for (int vb = 0; vb < 4; ++vb) { u32x2 w; w.x = cvt_pk_bf16(acc[db][vb][0], acc[db][vb][1]); w.y = cvt_pk_bf16(acc[db][vb][2], acc[db][vb][3]);
                *(u32x2*)(U + (vh * 64 + vb * 16 + c) * 64 + db * 16 + 4 * q) = w; }
        if (vh == 0) {
            float nn = 0.f; const LAS bf16_t* kr = (const LAS bf16_t*)(lds + MA_KT + (head * 64 + lane) * ML_PITCH);
            for (int s = 0; s < 64; ++s) nn += bf2f(kr[s]);
            ((float*)(a.ws + FW_NIN))[((size_t)bh * 64 + ck) * 64 + lane] = nn;
        }
    }
    __syncthreads();
}
__device__ __forceinline__ void mlstm_scan_item(const Args& a, LAS unsigned char* lds, const int item, const int tid) {
    const int bh = item >> 4, slice = item & 15, elem = slice * 512 + tid;
    LAS float* scs = (LAS float*)lds;
    if (tid < 128) scs[tid] = ld_f((const float*)(a.ws + FW_SC) + (size_t)bh * 128 + tid);
    __syncthreads();
    const bf16_t* U = (const bf16_t*)((const unsigned char*)a.out + OUT_USTATE) + (size_t)bh * 64 * 8192 + elem;
    bf16_t* Cst = (bf16_t*)((unsigned char*)a.out + OUT_CSTATE) + (size_t)bh * 64 * 8192 + elem;
    const float* nin = (const float*)(a.ws + FW_NIN) + (size_t)bh * 64 * 64 + tid; float* nst = (float*)(a.ws + FW_NST) + (size_t)bh * 64 * 64 + tid;
    float* mst = (float*)(a.ws + FW_MST) + bh * 64;
    const bool do_n = (slice == 0) && (tid < 64);
    float m = 0.f, C = 0.f, nv = 0.f;
    {
        float u[64], un[64];
#pragma unroll
        for (int j = 0; j < 64; ++j) { u[j] = bf2f(__builtin_nontemporal_load(U + (size_t)j * 8192)); un[j] = do_n ? __builtin_nontemporal_load(nin + j * 64) : 0.f; }
#pragma unroll
        for (int j = 0; j < 64; ++j) {
            const int ck = j; const float blast = scs[ck * 2], ac = scs[ck * 2 + 1];
            const float mn = fmaxf(blast + m, ac), dec = __expf(blast + m - mn), sc = __expf(ac - mn);
            Cst[(size_t)ck * 8192] = f2bf(C);
            if (do_n) nst[ck * 64] = nv;
            if (slice == 0 && tid == 0) mst[ck] = m;
            C = dec * C + sc * u[j]; nv = dec * nv + sc * un[j]; m = mn;
        }
    }
    __syncthreads();
}
constexpr int MC_KS = 0, MC_VT = 4 * 64 * ML_PITCH, MC_TAB = MC_VT + 4 * 128 * ML_PITCH;
__device__ __forceinline__ void mlstm_c_unit(const Args& a, const int l, LAS unsigned char* lds, const int unit, const int tid) {
    const bf16_t* proj = (const bf16_t*)(a.ws + FW_PROJ); const float* gates = (const float*)(a.ws + FW_GATES); bf16_t* mix = (bf16_t*)(a.ws + FW_MIX);
    const int wave = tid >> 6, lane = tid & 63, c = lane & 15, q = lane >> 4;
    const int b = unit >> 6, ck = unit & 63;
    const size_t t0 = (size_t)b * SEQ + ck * 64;
    const float* cw = a.in[I_CONVW] + l * 2048; const float* cb = a.in[I_CONVB] + l * 512;
    const int head = wave >> 1, th = wave & 1, bh = b * 4 + head;
    LAS float* tabB = (LAS float*)(lds + MC_TAB) + wave * 192; LAS float* tabG = tabB + 64; LAS float* tabM = tabB + 128;
    const float mc = ld_f((const float*)(a.ws + FW_MST) + bh * 64 + ck);
    {
        const size_t t = t0 + lane;
        const float li = gates[t * 8 + head], lf = logsigf(gates[t * 8 + 4 + head]);
        const float bc = scan_add(lf, lane), gg = li - bc, G = scan_max(gg, lane);
        tabB[lane] = bc; tabG[lane] = gg; tabM[lane] = fmaxf(mc, G);
    }
    const float* nst = (const float*)(a.ws + FW_NST) + ((size_t)bh * 64 + ck) * 64;
    f32x4 nv[2][2];
#pragma unroll
    for (int ks = 0; ks < 2; ++ks) { nv[ks][0] = __builtin_nontemporal_load((const f32x4*)(nst + ks * 32 + q * 8)); nv[ks][1] = __builtin_nontemporal_load((const f32x4*)(nst + ks * 32 + q * 8 + 4)); }
    bf16x8 qf[2][2]; float nq[2];
#pragma unroll
    for (int ti = 0; ti < 2; ++ti) {
        const int t = (th * 2 + ti) * 16 + c; float part = 0.f;
#pragma unroll
        for (int ks = 0; ks < 2; ++ks) { float y[8]; conv8(proj, t0 + t, ck * 64 + t, cw, cb, head * 64 + ks * 32 + q * 8, y);
#pragma unroll
            for (int j = 0; j < 4; ++j) part += y[j] * nv[ks][0][j] + y[4 + j] * nv[ks][1][j];
            qf[ti][ks] = pack8(y); }
        part += __shfl_xor(part, 16); part += __shfl_xor(part, 32); nq[ti] = part;
        asm volatile("" ::: "memory");
    }
    const bf16_t* Cst = (const bf16_t*)((const unsigned char*)a.out + OUT_CSTATE) + ((size_t)bh * 64 + ck) * 8192;
    {
        const int s = tid & 63, cg = tid >> 6;
        float y[32];
        conv32(proj, t0 + s, ck * 64 + s, cw, cb, 256 + cg * 32, y);
#pragma unroll
        for (int i = 0; i < 4; ++i) { float z[8];
#pragma unroll
            for (int j = 0; j < 8; ++j) z[j] = y[i * 8 + j] * 0.125f;
            *(LAS bf16x8*)(lds + MC_KS + ((cg >> 1) * 64 + s) * ML_PITCH + ((cg & 1) * 32 + i * 8) * 2) = pack8(z); }
        stage_vt(proj, t0, lds + MC_VT, tid);
    }
    u32x4 cfr[8][2];
#pragma unroll
    for (int vb = 0; vb < 8; ++vb)
#pragma unroll
        for (int ks = 0; ks < 2; ++ks) cfr[vb][ks] = __builtin_nontemporal_load((const u32x4*)(Cst + (vb * 16 + c) * 64 + ks * 32 + q * 8));
    __syncthreads();
    int c2 = c, q2 = q; asm volatile("" : "+v"(c2), "+v"(q2));
    f32x4 as[4][2];
#pragma unroll
    for (int sb = 0; sb < 4; ++sb)
#pragma unroll
        for (int ti = 0; ti < 2; ++ti) {
            as[sb][ti] = (f32x4){0.f, 0.f, 0.f, 0.f};
#pragma unroll
            for (int ks = 0; ks < 2; ++ks) { const bf16x8 kf = *(const LAS bf16x8*)(lds + MC_KS + (head * 64 + sb * 16 + c2) * ML_PITCH + ks * 64 + q2 * 16);
                as[sb][ti] = __builtin_amdgcn_mfma_f32_16x16x32_bf16(kf, qf[ti][ks], as[sb][ti], 0, 0, 0); }
        }
    float Mt[2], isc[2], rsum[2], bt[2];
#pragma unroll
    for (int ti = 0; ti < 2; ++ti) { const int t = (th * 2 + ti) * 16 + c2; Mt[ti] = tabM[t]; bt[ti] = tabB[t]; isc[ti] = __expf(mc - Mt[ti]); rsum[ti] = 0.f; }
#pragma unroll
    for (int sb = 0; sb < 4; ++sb)
#pragma unroll
        for (int r = 0; r < 4; ++r) { const int s = sb * 16 + 4 * q2 + r; const float gs = tabG[s];
#pragma unroll
            for (int ti = 0; ti < 2; ++ti) { const int t = (th * 2 + ti) * 16 + c2; const float dv = (s <= t) ? __expf(gs - Mt[ti]) : 0.f; const float v = as[sb][ti][r] * dv; as[sb][ti][r] = v; rsum[ti] += v; } }
    bf16x8 sf[2][2];
#pragma unroll
    for (int ti = 0; ti < 2; ++ti) { rsum[ti] += __shfl_xor(rsum[ti], 16); rsum[ti] += __shfl_xor(rsum[ti], 32);
#pragma unroll
        for (int kp = 0; kp < 2; ++kp) { float f[8];
#pragma unroll
            for (int r = 0; r < 4; ++r) { f[r] = as[2 * kp][ti][r]; f[4 + r] = as[2 * kp + 1][ti][r]; }
            sf[ti][kp] = pack8(f); } }
    f32x4 an[8][2];
#pragma unroll
    for (int vb = 0; vb < 8; ++vb) {
        an[vb][0] = (f32x4){0.f, 0.f, 0.f, 0.f}; an[vb][1] = an[vb][0];
#pragma unroll
        for (int ks = 0; ks < 2; ++ks) { const bf16x8 cf = __builtin_bit_cast(bf16x8, cfr[vb][ks]);
#pragma unroll
            for (int ti = 0; ti < 2; ++ti) an[vb][ti] = __builtin_amdgcn_mfma_f32_16x16x32_bf16(cf, qf[ti][ks], an[vb][ti], 0, 0, 0); }
#pragma unroll
        for (int ti = 0; ti < 2; ++ti) an[vb][ti] = an[vb][ti] * isc[ti];
#pragma unroll
        for (int kp = 0; kp < 2; ++kp) {
            const LAS unsigned char* vp = lds + MC_VT + (head * 128 + vb * 16 + c2) * ML_PITCH + (32 * kp + 4 * q2) * 2;
            const u32x2 lo = *(const LAS u32x2*)vp, hi = *(const LAS u32x2*)(vp + 32);
            const bf16x8 vf = __builtin_bit_cast(bf16x8, ((u32x4){lo.x, lo.y, hi.x, hi.y}));
#pragma unroll
            for (int ti = 0; ti < 2; ++ti) an[vb][ti] = __builtin_amdgcn_mfma_f32_16x16x32_bf16(vf, sf[ti][kp], an[vb][ti], 0, 0, 0);
        }
    }
    const float* mg = a.in[I_MNORMG] + l * 512 + head * 128;
#pragma unroll
    for (int ti = 0; ti < 2; ++ti) {
        const int t = (th * 2 + ti) * 16 + c2; const size_t tok = t0 + t;
        u32x2 orw[8];
#pragma unroll
        for (int vb = 0; vb < 8; ++vb) orw[vb] = *(const u32x2*)(proj + tok * NPROJ + 1792 + head * 128 + vb * 16 + 4 * q2);
        const float den = isc[ti] * nq[ti] + rsum[ti], dn = 1.f / fmaxf(fabsf(den), __expf(-(bt[ti] + Mt[ti])));
        float ss = 0.f;
#pragma unroll
        for (int vb = 0; vb < 8; ++vb) { an[vb][ti] = an[vb][ti] * dn; ss += (an[vb][ti][0] * an[vb][ti][0] + an[vb][ti][1] * an[vb][ti][1]) + (an[vb][ti][2] * an[vb][ti][2] + an[vb][ti][3] * an[vb][ti][3]); }
        ss += __shfl_xor(ss, 16); ss += __shfl_xor(ss, 32);
        const float rs = rsqrtf(ss * (1.f / 128.f) + 1e-6f);
#pragma unroll
        for (int vb = 0; vb < 8; ++vb) {
            const int v0 = vb * 16 + 4 * q2;
            const float o4[4] = {__uint_as_float(orw[vb].x << 16), __uint_as_float(orw[vb].x & 0xffff0000u), __uint_as_float(orw[vb].y << 16), __uint_as_float(orw[vb].y & 0xffff0000u)};
            const f32x4 g4 = *(const f32x4*)(mg + v0);
            float r4[4];
#pragma unroll
            for (int j = 0; j < 4; ++j) r4[j] = an[vb][ti][j] * rs * g4[j] * __builtin_amdgcn_rcpf(1.f + __expf(-o4[j]));
            u32x2 w; w.x = cvt_pk_bf16(r4[0], r4[1]); w.y = cvt_pk_bf16(r4[2], r4[3]);
            *(u32x2*)(mix + tok * D + 512 + head * 128 + v0) = w;
        }
    }
    __syncthreads();
}

__device__ __forceinline__ void tr_item(const float* W, int ldw, int nvalid, int k0, int n0, bf16_t* dst, int dpitch, int drow0, LAS float* scr, int lane, const float* gk) {
    const int nn = n0 + (lane & 31);
    const float* wp = W + (size_t)(k0 + (lane >> 5)) * ldw + nn;
    float v[32];
    if (nn < nvalid) {
#pragma unroll
        for (int i = 0; i < 32; ++i) v[i] = __builtin_nontemporal_load(wp + (size_t)(2 * i) * ldw);
    } else {
#pragma unroll
        for (int i = 0; i < 32; ++i) v[i] = 0.f;
    }
    const int c = lane & 7;
    f32x4 g0 = (f32x4){1.f, 1.f, 1.f, 1.f}, g1 = g0;
    if (gk) { g0 = *(const f32x4*)(gk + k0 + 8 * c); g1 = *(const f32x4*)(gk + k0 + 8 * c + 4); }
#pragma unroll
    for (int i = 0; i < 32; ++i) scr[(2 * i + (lane >> 5)) * 33 + (lane & 31)] = v[i];
    asm volatile("s_waitcnt lgkmcnt(0)" ::: "memory");
#pragma unroll
    for (int j = 0; j < 4; ++j) { const int n = (lane >> 3) + 8 * j; const LAS float* s = scr + (8 * c) * 33 + n;
        u32x4 o; o.x = pk2(s[0 * 33] * g0[0], s[1 * 33] * g0[1]); o.y = pk2(s[2 * 33] * g0[2], s[3 * 33] * g0[3]); o.z = pk2(s[4 * 33] * g1[0], s[5 * 33] * g1[1]); o.w = pk2(s[6 * 33] * g1[2], s[7 * 33] * g1[3]);
        *(u32x4*)(dst + (size_t)(drow0 + n) * dpitch + k0 + 8 * c) = o; }
    asm volatile("s_waitcnt lgkmcnt(0)" ::: "memory");
}
__device__ __forceinline__ void norm_row(const float* xrow, bf16_t* orow, float* ssqrow, int lane) {
    const f32x4* xr = (const f32x4*)xrow + lane;
    f32x4 v[4]; float s = 0.f;
#pragma unroll
    for (int j = 0; j < 4; ++j) { v[j] = xr[64 * j]; s += (v[j][0] * v[j][0] + v[j][1] * v[j][1]) + (v[j][2] * v[j][2] + v[j][3] * v[j][3]); }
    s = wave_sum(s);
    u32x2* o8 = (u32x2*)orow + lane;
#pragma unroll
    for (int j = 0; j < 4; ++j) { u32x2 w; w.x = pk2(v[j][0], v[j][1]); w.y = pk2(v[j][2], v[j][3]); o8[64 * j] = w; }
    if (lane < 16) ssqrow[lane] = (lane == 0) ? s : 0.f;
}

constexpr int CV_IN = 16 * 80, CV_OUT = 16 * 32, CV_G = 16 * 16 * 16, CV_D = 16 * 8 * 32, CV_LAYER = CV_IN + CV_OUT + 2 * CV_G + CV_D;
__device__ __forceinline__ void conv_item(const Args& a, int it, LAS float* scr, int lane) {
    unsigned char* ws = a.ws;
    const int l = it / CV_LAYER; int r = it % CV_LAYER;
    if (r < CV_IN) { const int kb = r / 80, nb = r % 80;
        tr_item(a.in[I_WIN] + (size_t)l * D * NIN, NIN, NIN, kb * 64, nb * 32, (bf16_t*)(ws + FW_WIN) + (size_t)l * WIN_ROWS * 1024, 1024, nb * 32, scr, lane, a.in[I_NMIXG] + l * D); return; }
    r -= CV_IN;
    if (r < CV_OUT) { const int kb = r / 32, nb = r % 32;
        tr_item(a.in[I_WOUT] + (size_t)l * D * D, D, D, kb * 64, nb * 32, (bf16_t*)(ws + FW_WOUT) + (size_t)l * 1024 * 1024, 1024, nb * 32, scr, lane, nullptr); return; }
    r -= CV_OUT;
    if (r < 2 * CV_G) { const int up = r / CV_G; r %= CV_G; const int e = r / 256, kb = (r % 256) / 16, nb = r % 16, n0 = nb * 32;
        const float* src = a.in[up ? I_WUP : I_WGATE] + ((size_t)l * 16 + e) * 1024 * 512;
        tr_item(src, 512, 512, kb * 64, n0, (bf16_t*)(ws + FW_WGU) + ((size_t)l * 16 + e) * 1024 * 1024, 1024, 256 * (n0 / 128) + (n0 % 128) + (up ? 128 : 0), scr, lane, a.in[I_NFFNG] + l * D); return; }
    r -= 2 * CV_G;
    { const int e = r / 256, kb = (r % 256) / 32, nb = r % 32;
        tr_item(a.in[I_WDOWN] + ((size_t)l * 16 + e) * 512 * 1024, 1024, 1024, kb * 64, nb * 32, (bf16_t*)(ws + FW_WD) + ((size_t)l * 16 + e) * 1024 * 512, 512, nb * 32, scr, lane, nullptr); }
}
__device__ __forceinline__ void conv_work(const Args& a, LAS unsigned char* lds, int begin, int end, int qword, int tid) {
    unsigned* counter = (unsigned*)(a.ws + FW_CTL) + CW_CONVQ + 64 * qword;
    LAS int* slot = (LAS int*)(lds + MISC_OFF + 8192);
    const int wave = __builtin_amdgcn_readfirstlane(tid >> 6), lane = tid & 63;
    LAS float* scr = (LAS float*)(lds + wave * 16384);
    for (;;) {
        __syncthreads();
        if (tid == 0) *slot = (int)__hip_atomic_fetch_add(counter, 1u, __ATOMIC_RELAXED, __HIP_MEMORY_SCOPE_AGENT);
        __syncthreads();
        const int base = begin + (*slot) * 16;
        if (base >= end) break;
#pragma unroll 1
        for (int j = 0; j < 2; ++j) { const int it = base + wave * 2 + j; if (it < end) conv_item(a, it, scr, lane); }
    }
}

constexpr int NPHASES = 15;

__device__ __forceinline__ void p0_prologue(const Args& a, LAS unsigned char* lds, int vcu, int G, int tid) {
    unsigned char* ws = a.ws;
    const int wave = __builtin_amdgcn_readfirstlane(tid >> 6), lane = tid & 63;
    const int gw = vcu * NWAVES + wave, NGW = G * NWAVES;
    for (int m = gw; m < T; m += NGW) norm_row(a.in[I_X] + (size_t)m * D, (bf16_t*)(ws + FW_XG) + (size_t)m * D, (float*)(ws + FW_SSQ) + (size_t)m * 16, lane);
    for (int idx = (int)blockIdx.x * NTHR + tid; idx < 2 * 24 * 1024; idx += G * NTHR) {
        const int l = idx / (24 * 1024), j = (idx / 1024) % 24, k = idx & 1023;
        float v = 0.f; if (j < 4) v = a.in[I_WRG][((size_t)l * D + k) * 4 + j]; else if (j < 20) v = a.in[I_WRE][((size_t)l * D + k) * 16 + (j - 4)];
        v *= a.in[I_NFFNG][l * D + k];
        const bf16_t h = f2bf(v), lo = f2bf(v - bf2f(h));
        bf16_t* rt = (bf16_t*)(ws + FW_RT) + (size_t)l * 48 * 1024;
        rt[j * 1024 + k] = h; rt[(24 + j) * 1024 + k] = lo;
    }
    conv_work(a, lds, 0, CV_IN, 0, tid);
}

#define XB_TMO      128
#define XB_XCNT(j)  (256  + 64 * (j))
#define XB_XSUB(j)  (1280 + 64 * (j))
#define XB_XGEN(j)  (2304 + 64 * (j))
#define XB_TOP      3328
#define XB_TOPGEN   3392
#define XCD_BAR_WORDS 3456
#define XB_SPIN_CAP (1u << 18)
__device__ __forceinline__ unsigned xb_ld(unsigned* p)              { return __hip_atomic_load(p, __ATOMIC_RELAXED, __HIP_MEMORY_SCOPE_AGENT); }
__device__ __forceinline__ unsigned xb_add(unsigned* p, unsigned v) { return __hip_atomic_fetch_add(p, v, __ATOMIC_RELAXED, __HIP_MEMORY_SCOPE_AGENT); }
__device__ __forceinline__ unsigned xb_xcc_id() { return (unsigned)__builtin_amdgcn_s_getreg((3 << 11) | 20) & 0xFu; }
#define XB_SPIN(cond, bar) do { unsigned _sp = 0; while (cond) { __builtin_amdgcn_s_sleep(1); \
    if ((++_sp & 255u) == 0u) { if (xb_ld(&(bar)[XB_TMO])) break; if (_sp > XB_SPIN_CAP) { atomicAdd(&(bar)[XB_TMO], 1u); break; } } } } while (0)
struct XcdBarrier { unsigned* bar; unsigned x; volatile LAS unsigned* st; int swave; };
__device__ __forceinline__ XcdBarrier xcd_barrier_post(unsigned* bar, volatile LAS unsigned* st, bool tid0) {
    XcdBarrier b; b.bar = bar; b.x = xb_xcc_id(); b.st = st; b.swave = 0;
    if (tid0) (void)xb_add(&bar[XB_XCNT(b.x)], 1u);
    return b;
}
__device__ __forceinline__ void xcd_barrier_complete(unsigned* bar, unsigned x, unsigned& nloc, unsigned& nx) {
    const unsigned G = gridDim.x * gridDim.y * gridDim.z;
    unsigned sum, cnt, mine, sp = 0u;
    for (;;) {
        sum = 0u; cnt = 0u; mine = 0u;
#pragma unroll
        for (unsigned j = 0; j < 16; ++j) { const unsigned c = xb_ld(&bar[XB_XCNT(j)]); sum += c; cnt += (c > 0u) ? 1u : 0u; mine = (j == x) ? c : mine; }
        if (sum == G) break;
        __builtin_amdgcn_s_sleep(1);
        if ((++sp & 255u) == 0u) { if (xb_ld(&bar[XB_TMO])) break; if (sp > XB_SPIN_CAP) { atomicAdd(&bar[XB_TMO], 1u); break; } }
    }
    nloc = mine > 0u ? mine : 1u; nx = cnt > 0u ? cnt : 1u;
}
__device__ __forceinline__ void xcd_barrier(const XcdBarrier& b) {
    asm volatile("s_waitcnt vmcnt(0)" ::: "memory");
    __syncthreads();
    if (tid_of(b.swave) == 0) {
        unsigned* bar = b.bar;
        __builtin_amdgcn_s_waitcnt(0);
        unsigned nloc = b.st[0], nx = b.st[1];
        if (nloc == 0u) { xcd_barrier_complete(bar, b.x, nloc, nx); b.st[0] = nloc; b.st[1] = nx; }
        const unsigned old = xb_add(&bar[XB_XSUB(b.x)], 1u);
        const unsigned gen = old / nloc;
        if (old + 1u == (gen + 1u) * nloc) {
            __builtin_amdgcn_fence(__ATOMIC_RELEASE, "agent");
            asm volatile("s_waitcnt vmcnt(0)" ::: "memory");
            const unsigned og = xb_add(&bar[XB_TOP], 1u);
            const unsigned tg = og / nx;
            if (og + 1u == (tg + 1u) * nx) xb_add(&bar[XB_TOPGEN], 1u);
            else XB_SPIN(xb_ld(&bar[XB_TOPGEN]) == tg, bar);
            __builtin_amdgcn_fence(__ATOMIC_ACQUIRE, "agent");
            xb_add(&bar[XB_XGEN(b.x)], 1u);
            asm volatile("s_waitcnt vmcnt(0)" ::: "memory");
        } else {
            XB_SPIN(xb_ld(&bar[XB_XGEN(b.x)]) == gen, bar);
            __builtin_amdgcn_fence(__ATOMIC_ACQUIRE, "agent");
            asm volatile("s_waitcnt vmcnt(0)" ::: "memory");
        }
    }
    __syncthreads();
}

#define IN(k) (lo <= (k) && (k) < hi)
#define STAMP(k) do { } while (0)
#define SEAM(k) do { if (IN(k) && IN((k) + 1)) xcd_barrier(bar); STAMP((k) + 1); } while (0)
#ifndef MOE_SPLIT
#define MOE_SPLIT(layer, seg) 0
#endif
#define PHASE(k, ...) do { if (IN(k)) { __VA_ARGS__ } } while (0)
template <int L>
__device__ __forceinline__ void layer_phases(const Args& args, LAS unsigned char* lds, const int lo, const int hi, const int G, const int bx, const int vcu, const XcdBarrier& bar, const int swave) {
    unsigned char* ws = args.ws;
    constexpr int l = L, base = 1 + 7 * L;
    constexpr int Q0b = (L == 0) ? CV_IN : CV_LAYER + CV_IN + CV_OUT + CV_G, Q0e = (L == 0) ? CV_IN + CV_OUT + 2 * CV_G : 2 * CV_LAYER;
    constexpr int Q1b = (L == 0) ? CV_IN + CV_OUT + 2 * CV_G : 0, Q1e = (L == 0) ? CV_LAYER : 0;
    constexpr int Q6b = (L == 0) ? CV_LAYER : 0, Q6e = (L == 0) ? CV_LAYER + CV_IN + CV_OUT + CV_G : 0;
    PHASE(base + 0,
        DenseOrder S; S.init(T, WIN_ROWS, G, bx, ws + FW_XG, 1024, (bf16_t*)(ws + FW_WIN) + (size_t)l * WIN_ROWS * 1024, 1024);
        EpiInProj E{(const float*)(ws + FW_SSQ), (bf16_t*)(ws + FW_PROJ), (float*)(ws + FW_GATES), args.in[I_GATEB] + l * 8};
        gemm_phase<EpiInProj, DenseOrder, false>(lds, 1024, 1024, 16, S, E, swave);
        if (Q0e > Q0b) { int t_ = tid_of(swave); asm volatile("" : "+v"(t_)); conv_work(args, lds, Q0b, Q0e, base + 0, t_); }
    );
    SEAM(base + 0);
    PHASE(base + 1,
        for (int u = bx; u < 256; u += G) { int t_ = tid_of(swave); asm volatile("" : "+v"(t_)); attn_unit(args, l, lds, u, t_); }
        for (int u = bx; u < 256; u += G) { int t_ = tid_of(swave); asm volatile("" : "+v"(t_)); mlstm_a_unit(args, l, lds, u, t_); }
        if (Q1e > Q1b) { int t_ = tid_of(swave); asm volatile("" : "+v"(t_)); conv_work(args, lds, Q1b, Q1e, base + 1, t_); }
    );
    SEAM(base + 1);
    PHASE(base + 2, for (int u = bx; u < 256; u += G) { int t_ = tid_of(swave); asm volatile("" : "+v"(t_)); mlstm_scan_item(args, lds, u, t_); } );
    SEAM(base + 2);
    PHASE(base + 3, for (int u = bx; u < 256; u += G) { int t_ = tid_of(swave); asm volatile("" : "+v"(t_)); mlstm_c_unit(args, l, lds, u, t_); } );
    SEAM(base + 3);
    PHASE(base + 4,
        DenseOrder S; S.init(T, 1024, G, bx, ws + FW_MIX, 1024, (bf16_t*)(ws + FW_WOUT) + (size_t)l * 1024 * 1024, 1024);
        EpiResid<false, false> E{(bf16_t*)(ws + FW_XG), nullptr, (float*)(ws + FW_SSQ)};
        gemm_phase<EpiResid<false, false>, DenseOrder, false>(lds, 1024, 1024, 16, S, E, swave);
    );
    SEAM(base + 4);
    PHASE(base + 5, int t_ = tid_of(swave); asm volatile("" : "+v"(t_)); route1_phase(args, l, lds, bx, G, t_); );
    SEAM(base + 5);
    PHASE(base + 6,
        LAS int* tb = (LAS int*)(lds + MISC_OFF + 12288);
        if (tid_of(swave) == 0) { int run = 0; const int* bc = (const int*)(ws + FW_CTL) + CW_BCNT + 64 * l;
            for (int b = 0; b < 24; ++b) { const int cb = ld_ctl(bc + b); tb[b] = run; tb[32 + b] = cb; run += (cb + 255) >> 8; }
            tb[24] = run; }
        __syncthreads();
        MoeOrder S; S.ntile = __builtin_amdgcn_readfirstlane(tb[24]); S.nup8 = S.ntile; S.ndn4 = S.ntile; S.pad_ = 0; S.G = G; S.c = vcu; S.tb = tb; S.rowtokb = (const int*)(ws + FW_ROWTOKB); S.xb = (const char*)(ws + FW_XG);
        S.wgu = (const char*)((bf16_t*)(ws + FW_WGU) + (size_t)l * 16 * 1024 * 1024); S.act = (const char*)(ws + FW_PROJ); S.wd = (const char*)((bf16_t*)(ws + FW_WD) + (size_t)l * 16 * 1024 * 512);
        S.upcnt = (unsigned*)(ws + FW_CTL) + CW_UPCNT + 128 * l;
        EpiMoe<L == 1> E{EpiUp{(bf16_t*)(ws + FW_PROJ), (const float*)(ws + FW_RW), S.upcnt}, EpiResid<true, L == 1>{(bf16_t*)(ws + FW_XG), args.out, (float*)(ws + FW_SSQ)}};
        _Pragma("unroll 1") for (int seg = 0; seg < 2; ++seg) { S.nup8 = seg ? 0 : S.ntile; S.ndn4 = seg ? S.ntile : 0; S.pad_ = MOE_SPLIT(L, seg); gemm_phase<EpiMoe<L == 1>, MoeOrder, true>(lds, 1024, 1024, 16, S, E, swave); }
        if (Q6e > Q6b) { int t_ = tid_of(swave); asm volatile("" : "+v"(t_)); conv_work(args, lds, Q6b, Q6e, base + 6, t_); }
    );
    SEAM(base + 6);
}

__global__ void __launch_bounds__(NTHR, 2) fwd(Args args) {
    extern __shared__ __attribute__((aligned(16))) unsigned char lds_raw[];
    LAS unsigned char* lds = (LAS unsigned char*)lds_raw;
    const int G = gridDim.x; const int bx = blockIdx.x; const int vcu = (G % 8 == 0) ? (bx % 8) * (G / 8) + bx / 8 : bx;
    const int lo = args.ph_lo, hi = args.ph_hi;
    const int swave = __builtin_amdgcn_readfirstlane((int)threadIdx.x >> 6);
    volatile LAS unsigned* bst = (volatile LAS unsigned*)(lds + MISC_OFF + 4096);
    if (tid_of(swave) < 2) bst[tid_of(swave)] = 0u;
    __syncthreads();
    XcdBarrier bar; bar.bar = (unsigned*)(args.ws + FW_CTL) + CW_BAR; bar.x = 0; bar.st = bst; bar.swave = swave;
    if (hi - lo > 1) { bar = xcd_barrier_post((unsigned*)(args.ws + FW_CTL) + CW_BAR, bst, tid_of(swave) == 0); bar.swave = swave; }
    STAMP(0);
    PHASE(0, int t_ = tid_of(swave); asm volatile("" : "+v"(t_)); p0_prologue(args, lds, vcu, G, t_); );
    SEAM(0);
    layer_phases<0>(args, lds, lo, hi, G, bx, vcu, bar, swave);
    layer_phases<1>(args, lds, lo, hi, G, bx, vcu, bar, swave);
}
#undef IN
#undef SEAM
#undef PHASE
}

extern "C" void kernel_launch(void* const* d_in, const int* in_sizes, int n_in, void* d_out, int out_size, void* d_ws, size_t ws_size, hipStream_t stream) {
    static int grid = 0;
    if (grid == 0) {
        int dev = 0, cus = 0, per_cu = 0;
        if (hipGetDevice(&dev) != hipSuccess || hipDeviceGetAttribute(&cus, hipDeviceAttributeMultiprocessorCount, dev) != hipSuccess) { fprintf(stderr, "kernel_launch: device query failed\n"); grid = -1; return; }
        if (hipFuncSetAttribute((const void*)fk::fwd, hipFuncAttributeMaxDynamicSharedMemorySize, fk::LDS_BYTES) != hipSuccess) { fprintf(stderr, "kernel_launch: hipFuncSetAttribute failed\n"); grid = -1; return; }
        if (hipOccupancyMaxActiveBlocksPerMultiprocessor(&per_cu, (const void*)fk::fwd, fk::NTHR, fk::LDS_BYTES) != hipSuccess || per_cu < 1) { fprintf(stderr, "kernel_launch: occupancy query says %d blocks per CU\n", per_cu); per_cu = 1; }
        (void)hipGetLastError();
        grid = cus;
        fprintf(stderr, "kernel_launch: grid %d, per_cu %d, ws_size %zu\n", grid, per_cu, ws_size);
    }
    if (grid < 0) return;
    float* out = (float*)d_out;
    unsigned char* ws = (unsigned char*)d_ws;
    fk::Args a{};
    for (int i = 0; i < 20; ++i) a.in[i] = (const float*)d_in[i];
    a.out = out; a.ws = ws;
    (void)hipMemsetAsync(ws + fk::FW_CTL, 0, 64 * 1024, stream);
    auto run = [&](int lo, int hi) { a.ph_lo = lo; a.ph_hi = hi; hipLaunchKernelGGL(fk::fwd, dim3(grid), dim3(fk::NTHR), fk::LDS_BYTES, stream, a); };
    run(0, fk::NPHASES);
}
```

```cpp
#include <hip/hip_runtime.h>
#include <cstdio>
#include <cstdint>

typedef unsigned short bf16_t;
constexpr int T = 16384, SEQ = 4096, D = 1024, NIN = 2312, NPROJ = 2304;
constexpr size_t MiB = 1u << 20;
constexpr size_t WS_XG = 16 * MiB;
constexpr size_t WS_SSQ = 48 * MiB;
constexpr size_t WS_GATES = 49 * MiB;
constexpr size_t WS_ROUTE_B = 50 * MiB;
constexpr size_t WS_ROUTE_W = 51 * MiB;
constexpr size_t WS_PROJ = 52 * MiB;
constexpr size_t WS_MIX = 124 * MiB;
constexpr size_t WS_QKC = 156 * MiB;
constexpr size_t WS_HM = 188 * MiB;

__device__ __forceinline__ float bf2f(bf16_t v) { return __uint_as_float((unsigned)v << 16); }
__device__ __forceinline__ bf16_t f2bf(float f) { unsigned u = __float_as_uint(f); return (bf16_t)((u + 0x7fffu + ((u >> 16) & 1u)) >> 16); }
__device__ __forceinline__ float wave_sum(float v) {
#pragma unroll
    for (int o = 1; o < 64; o <<= 1) v += __shfl_xor(v, o);
    return v;
}
__device__ __forceinline__ float wave_max(float v) {
#pragma unroll
    for (int o = 1; o < 64; o <<= 1) v = fmaxf(v, __shfl_xor(v, o));
    return v;
}
__device__ __forceinline__ float siluf(float x) { return x / (1.f + __expf(-x)); }
__device__ __forceinline__ float sigmoidf(float x) { return 1.f / (1.f + __expf(-x)); }

__global__ void nv_norm(const float* __restrict__ x, const float* __restrict__ g, bf16_t* __restrict__ xg, float* __restrict__ ssq) {
    const int row = blockIdx.x * 4 + (threadIdx.x >> 6), lane = threadIdx.x & 63;
    const float4* xr = (const float4*)(x + (size_t)row * D);
    const float4* gr = (const float4*)g;
    float s = 0.f; float4 v[4];
#pragma unroll
    for (int j = 0; j < 4; ++j) { v[j] = xr[lane + 64 * j]; s += v[j].x * v[j].x + v[j].y * v[j].y + v[j].z * v[j].z + v[j].w * v[j].w; }
    s = wave_sum(s);
#pragma unroll
    for (int j = 0; j < 4; ++j) {
        const float4 gg = gr[lane + 64 * j];
        bf16_t* o = xg + (size_t)row * D + 4 * (lane + 64 * j);
        o[0] = f2bf(v[j].x * gg.x); o[1] = f2bf(v[j].y * gg.y); o[2] = f2bf(v[j].z * gg.z); o[3] = f2bf(v[j].w * gg.w);
    }
    if (lane < 16) ssq[(size_t)row * 16 + lane] = (lane == 0) ? s : 0.f;
}

__device__ __forceinline__ float row_rstd(const float* ssq, int row) {
    float s = 0.f;
#pragma unroll
    for (int i = 0; i < 16; ++i) s += ssq[(size_t)row * 16 + i];
    return rsqrtf(s * (1.f / D) + 1e-6f);
}

struct GemmEpi {
    int mode;
    const float* ssq;
    bf16_t* proj; float* gates; const float* gate_b;
    const float* xin; float* out;
};
__global__ void __launch_bounds__(256) nv_gemm(const bf16_t* __restrict__ A, int lda, const float* __restrict__ B, int ldb, int N, int K, GemmEpi e) {
    __shared__ float As[16][65];
    __shared__ float Bs[16][65];
    const int tx = threadIdx.x & 15, ty = threadIdx.x >> 4;
    const int m0 = blockIdx.y * 64, n0 = blockIdx.x * 64;
    float acc[4][4];
#pragma unroll
    for (int i = 0; i < 4; ++i)
#pragma unroll
        for (int j = 0; j < 4; ++j) acc[i][j] = 0.f;
    for (int k0 = 0; k0 < K; k0 += 16) {
        {
            const int r = threadIdx.x >> 2, c = (threadIdx.x & 3) * 4;
            const bf16_t* ap = A + (size_t)(m0 + r) * lda + k0 + c;
#pragma unroll
            for (int i = 0; i < 4; ++i) As[c + i][r] = bf2f(ap[i]);
        }
        {
            const int r = threadIdx.x >> 4, c = (threadIdx.x & 15) * 4;
#pragma unroll
            for (int i = 0; i < 4; ++i) { const int n = n0 + c + i; Bs[r][c + i] = (n < N) ? B[(size_t)(k0 + r) * ldb + n] : 0.f; }
        }
        __syncthreads();
#pragma unroll
        for (int kk = 0; kk < 16; ++kk) {
            float a[4], b[4];
#pragma unroll
            for (int i = 0; i < 4; ++i) { a[i] = As[kk][ty * 4 + i]; b[i] = Bs[kk][tx * 4 + i]; }
#pragma unroll
            for (int i = 0; i < 4; ++i)
#pragma unroll
                for (int j = 0; j < 4; ++j) acc[i][j] += a[i] * b[j];
        }
        __syncthreads();
    }
#pragma unroll
    for (int i = 0; i < 4; ++i) {
        const int row = m0 + ty * 4 + i;
        float rs = 1.f;
        if (e.mode == 0) rs = row_rstd(e.ssq, row);
#pragma unroll
        for (int j = 0; j < 4; ++j) {
            const int n = n0 + tx * 4 + j;
            if (n >= N) continue;
            if (e.mode == 0) {
                const float v = acc[i][j] * rs;
                if (n < NPROJ) e.proj[(size_t)row * NPROJ + n] = f2bf(v);
                else e.gates[(size_t)row * 8 + (n - NPROJ)] = v + e.gate_b[n - NPROJ];
            } else {
                e.out[(size_t)row * D + n] = e.xin[(size_t)row * D + n] + acc[i][j];
            }
        }
    }
}

__device__ __forceinline__ int t5_bucket(int dist) {
    if (dist < 16) return dist;
    const float d = (float)dist;
    int large = 16 + (int)(logf(d / 16.f) / logf(8.f) * 16.f);
    return large < 31 ? large : 31;
}
__global__ void __launch_bounds__(256) nv_attn(const bf16_t* __restrict__ proj, const float* __restrict__ qg, const float* __restrict__ kg,
                                               const float* __restrict__ sink, const float* __restrict__ rel_bias, bf16_t* __restrict__ mix) {
    __shared__ float qs[4][64];
    __shared__ float ps[4][128];
    const int w = threadIdx.x >> 6, lane = threadIdx.x & 63;
    const int item = blockIdx.x * 4 + w;
    const int t = item >> 3, h = item & 7, kvh = h >> 2;
    const int tpos = t & (SEQ - 1);
    const float qv = bf2f(proj[(size_t)t * NPROJ + h * 64 + lane]);
    const float qss = wave_sum(qv * qv);
    qs[w][lane] = qv * rsqrtf(qss * (1.f / 64.f) + 1e-6f) * qg[lane];
    __syncthreads();
    float sc[2];
#pragma unroll
    for (int half = 0; half < 2; ++half) {
        const int j = lane + 64 * half;
        const int dist = 127 - j;
        if (tpos - dist < 0) { sc[half] = -INFINITY; continue; }
        const bf16_t* kp = proj + (size_t)(t - dist) * NPROJ + 512 + kvh * 64;
        float kss = 0.f, dot = 0.f;
        for (int d = 0; d < 64; ++d) { const float kv = bf2f(kp[d]); kss += kv * kv; dot += kv * kg[d] * qs[w][d]; }
        dot *= rsqrtf(kss * (1.f / 64.f) + 1e-6f);
        sc[half] = dot * 0.125f + rel_bias[t5_bucket(dist) * 8 + h];
    }
    const float sk = sink[h];
    const float m = fmaxf(wave_max(fmaxf(sc[0], sc[1])), sk);
    const float p0 = __expf(sc[0] - m), p1 = __expf(sc[1] - m);
    const float den = wave_sum(p0 + p1) + __expf(sk - m);
    ps[w][lane] = p0 / den; ps[w][lane + 64] = p1 / den;
    __syncthreads();
    float o = 0.f;
    for (int j = 0; j < 128; ++j) {
        const int dist = 127 - j;
        if (tpos - dist < 0) continue;
        o += ps[w][j] * bf2f(proj[(size_t)(t - dist) * NPROJ + 640 + kvh * 64 + lane]);
    }
    mix[(size_t)t * D + h * 64 + lane] = f2bf(o);
}

__global__ void nv_conv(const bf16_t* __restrict__ proj, const float* __restrict__ cw, const float* __restrict__ cb, float* __restrict__ qkc) {
    const int idx = blockIdx.x * 256 + threadIdx.x;
    const int t = idx >> 9, c = idx & 511, tpos = t & (SEQ - 1);
    float y = cb[c];
#pragma unroll
    for (int j = 0; j < 4; ++j) { const int dt = 3 - j; if (tpos - dt >= 0) y += cw[j * 512 + c] * bf2f(proj[(size_t)(t - dt) * NPROJ + 768 + c]); }
    y = siluf(y);
    if (c >= 256) y *= 0.125f;
    qkc[(size_t)t * 512 + c] = y;
}
__global__ void __launch_bounds__(64) nv_mlstm(const float* __restrict__ qkc, const bf16_t* __restrict__ proj, const float* __restrict__ gates, float* __restrict__ hm) {
    const int bh = blockIdx.x >> 3, vs = blockIdx.x & 7, b = bh >> 2, h = bh & 3;
    const int lane = threadIdx.x, v = vs * 16 + (lane & 15), dq = lane >> 4;
    float C[16], n[16];
#pragma unroll
    for (int i = 0; i < 16; ++i) { C[i] = 0.f; n[i] = 0.f; }
    float m = 0.f;
    for (int s = 0; s < SEQ; ++s) {
        const size_t t = (size_t)b * SEQ + s;
        const float li = gates[t * 8 + h], fp = gates[t * 8 + 4 + h];
        const float lf = fminf(fp, 0.f) - log1pf(__expf(-fabsf(fp)));
        const float mn = fmaxf(lf + m, li);
        const float fd = __expf(lf + m - mn), ig = __expf(li - mn);
        m = mn;
        const float vv = bf2f(proj[t * NPROJ + 1280 + h * 128 + v]);
        const float4* qp = (const float4*)(qkc + t * 512 + h * 64 + dq * 16);
        const float4* kp = (const float4*)(qkc + t * 512 + 256 + h * 64 + dq * 16);
        float num = 0.f, den = 0.f;
#pragma unroll
        for (int i4 = 0; i4 < 4; ++i4) {
            const float4 q4 = qp[i4], k4 = kp[i4];
            const float qa[4] = {q4.x, q4.y, q4.z, q4.w}, ka[4] = {k4.x, k4.y, k4.z, k4.w};
#pragma unroll
            for (int i = 0; i < 4; ++i) {
                const int ii = i4 * 4 + i;
                C[ii] = fd * C[ii] + ig * vv * ka[i];
                n[ii] = fd * n[ii] + ig * ka[i];
                num += C[ii] * qa[i]; den += n[ii] * qa[i];
            }
        }
        num += __shfl_xor(num, 16); num += __shfl_xor(num, 32);
        den += __shfl_xor(den, 16); den += __shfl_xor(den, 32);
        const float hv = num / fmaxf(fabsf(den), __expf(-m));
        if (dq == 0) hm[t * 512 + h * 128 + v] = hv;
    }
}
__global__ void __launch_bounds__(256) nv_mnorm(const float* __restrict__ hm, const bf16_t* __restrict__ proj, const float* __restrict__ g, bf16_t* __restrict__ mix) {
    const int item = blockIdx.x * 4 + (threadIdx.x >> 6), lane = threadIdx.x & 63;
    const int t = item >> 2, h = item & 3;
    const float a = hm[(size_t)t * 512 + h * 128 + lane], c = hm[(size_t)t * 512 + h * 128 + 64 + lane];
    const float rs = rsqrtf(wave_sum(a * a + c * c) * (1.f / 128.f) + 1e-6f);
    const float o0 = bf2f(proj[(size_t)t * NPROJ + 1792 + h * 128 + lane]), o1 = bf2f(proj[(size_t)t * NPROJ + 1792 + h * 128 + 64 + lane]);
    mix[(size_t)t * D + 512 + h * 128 + lane] = f2bf(a * rs * g[h * 128 + lane] * sigmoidf(o0));
    mix[(size_t)t * D + 512 + h * 128 + 64 + lane] = f2bf(c * rs * g[h * 128 + 64 + lane] * sigmoidf(o1));
}

__global__ void __launch_bounds__(256) nv_route(const bf16_t* __restrict__ hg, const float* __restrict__ ssq, const float* __restrict__ wrg, const float* __restrict__ brg,
                                                const float* __restrict__ wre, const float* __restrict__ bre, int* __restrict__ rb, float* __restrict__ rw) {
    const int t = blockIdx.x * 4 + (threadIdx.x >> 6), lane = threadIdx.x & 63;
    float acc[20];
#pragma unroll
    for (int j = 0; j < 20; ++j) acc[j] = 0.f;
    for (int i = 0; i < 16; ++i) {
        const int k = lane + 64 * i;
        const float xv = bf2f(hg[(size_t)t * D + k]);
#pragma unroll
        for (int j = 0; j < 4; ++j) acc[j] += xv * wrg[k * 4 + j];
#pragma unroll
        for (int j = 0; j < 16; ++j) acc[4 + j] += xv * wre[k * 16 + j];
    }
#pragma unroll
    for (int j = 0; j < 20; ++j) acc[j] = wave_sum(acc[j]);
    if (lane == 0) {
        const float rs = row_rstd(ssq, t);
        float gl[4]; int grp = 0;
#pragma unroll
        for (int j = 0; j < 4; ++j) { gl[j] = acc[j] * rs + brg[j]; }
#pragma unroll
        for (int j = 1; j < 4; ++j) if (gl[j] > gl[grp]) grp = j;
        float gs = 0.f;
#pragma unroll
        for (int j = 0; j < 4; ++j) gs += __expf(gl[j] - gl[grp]);
        const float pg = 1.f / gs;
        float el[4];
#pragma unroll
        for (int j = 0; j < 4; ++j) {
            float v = 0.f;
#pragma unroll
            for (int q = 0; q < 4; ++q) if (q == grp) v = acc[4 + q * 4 + j] * rs + bre[q * 4 + j];
            el[j] = v;
        }
        int i0 = 0;
#pragma unroll
        for (int j = 1; j < 4; ++j) if (el[j] > el[i0]) i0 = j;
        int i1 = (i0 == 0) ? 1 : 0;
#pragma unroll
        for (int j = 0; j < 4; ++j) if (j != i0 && el[j] > el[i1]) i1 = j;
        const float w0 = 1.f / (1.f + __expf(el[i1] - el[i0])), w1 = 1.f - w0;
        const int lo = i0 < i1 ? i0 : i1, hi = i0 < i1 ? i1 : i0;
        const float wlo = (i0 < i1 ? w0 : w1) * pg, whi = (i0 < i1 ? w1 : w0) * pg;
        const int pidx = (lo == 0) ? (hi - 1) : ((lo == 1) ? (hi + 1) : 5);
        rb[t] = grp * 6 + pidx; rw[t * 4] = wlo; rw[t * 4 + 1] = whi; rw[t * 4 + 2] = rs; rw[t * 4 + 3] = 0.f;
    }
}
__device__ __forceinline__ void pair_decode(int p, int& lo, int& hi) { lo = (p < 3) ? 0 : ((p < 5) ? 1 : 2); hi = (p < 3) ? p + 1 : ((p < 5) ? p - 1 : 3); }
__global__ void __launch_bounds__(512) nv_moe(const bf16_t* __restrict__ hg, const float* __restrict__ ssq, const int* __restrict__ rb, const float* __restrict__ rw,
                                              const float* __restrict__ wg, const float* __restrict__ wu, const float* __restrict__ wd, float* __restrict__ out) {
    __shared__ float xs[1024];
    __shared__ float act[1024];
    const int t = blockIdx.x, j = threadIdx.x;
    const float rs = row_rstd(ssq, t);
    xs[j] = bf2f(hg[(size_t)t * D + j]) * rs; xs[j + 512] = bf2f(hg[(size_t)t * D + j + 512]) * rs;
    __syncthreads();
    const int bk = rb[t], grp = bk / 6; int lo, hi; pair_decode(bk % 6, lo, hi);
    const int e2[2] = {grp * 4 + lo, grp * 4 + hi};
#pragma unroll
    for (int s = 0; s < 2; ++s) {
        const float* g = wg + (size_t)e2[s] * 1024 * 512; const float* u = wu + (size_t)e2[s] * 1024 * 512;
        float ga = 0.f, ua = 0.f;
        for (int k = 0; k < 1024; ++k) { ga += xs[k] * g[(size_t)k * 512 + j]; ua += xs[k] * u[(size_t)k * 512 + j]; }
        act[s * 512 + j] = siluf(ga) * ua * rw[t * 4 + s];
    }
    __syncthreads();
#pragma unroll
    for (int c = 0; c < 2; ++c) {
        const int col = j + 512 * c; float y = 0.f;
#pragma unroll
        for (int s = 0; s < 2; ++s) {
            const float* dw = wd + (size_t)e2[s] * 512 * 1024;
            for (int i = 0; i < 512; ++i) y += act[s * 512 + i] * dw[(size_t)i * 1024 + col];
        }
        out[(size_t)t * D + col] += y;
    }
}


namespace fk {
#define LAS __attribute__((address_space(3)))
typedef short bf16x8 __attribute__((ext_vector_type(8)));
typedef float f32x4 __attribute__((ext_vector_type(4)));
typedef float f32x2 __attribute__((ext_vector_type(2)));
typedef unsigned u32x4 __attribute__((ext_vector_type(4)));
typedef unsigned u32x2 __attribute__((ext_vector_type(2)));
constexpr int NWAVES = 8, NTHR = 512;
constexpr int BM = 256, BK = 64, HALF = 128, HTB = HALF * BK * 2, STAGE_BYTES = 8 * HTB;
constexpr int LDS_BYTES = 147456;
constexpr int MISC_OFF = STAGE_BYTES;
constexpr size_t FW_CTL = 0;
constexpr size_t FW_WIN = 1 * MiB;
constexpr size_t FW_WOUT = 11 * MiB;
constexpr size_t FW_WGU = 15 * MiB;
constexpr size_t FW_XB8 = 47 * MiB;
constexpr size_t FW_WD = 79 * MiB;
constexpr size_t FW_XG = 111 * MiB;
constexpr size_t FW_PROJ = 143 * MiB;
constexpr size_t FW_MIX = 215 * MiB;
constexpr size_t FW_SSQ = 247 * MiB;
constexpr size_t FW_GATES = 248 * MiB;
constexpr size_t FW_RB = 249 * MiB;
constexpr size_t FW_RW = FW_RB + 65536;
constexpr size_t FW_LPOS = FW_RW + 262144;
constexpr size_t FW_CNT = FW_LPOS + 65536;
constexpr size_t FW_ROWTOK = FW_CNT + 32768;
constexpr size_t FW_ROWW = FW_ROWTOK + 131072;
constexpr size_t FW_TILEB = FW_ROWW + 524288;
constexpr size_t FW_NIN = FW_TILEB + 4096;
constexpr size_t FW_NST = FW_NIN + 262144;
constexpr size_t FW_SC = FW_NST + 262144;
constexpr size_t FW_MST = FW_SC + 8192;
constexpr size_t FW_RT = FW_MST + 4096;
constexpr size_t OUT_USTATE = 0;
constexpr size_t OUT_CSTATE = 16 * MiB;
constexpr size_t FW_ROWTOKB = 252 * MiB;
constexpr int CW_CONVQ = 512, CW_BAR = 4096, CW_BCNT = 8192, CW_UPCNT = 8704;
constexpr int MAXROWS = 16384 + 24 * 256;
constexpr int WIN_ROWS = 2560;

__device__ __forceinline__ unsigned pk2(float lo, float hi) { return (unsigned)f2bf(lo) | ((unsigned)f2bf(hi) << 16); }
typedef __bf16 bf16x2_t __attribute__((ext_vector_type(2)));
__device__ __forceinline__ unsigned cvt_pk_op(float lo, float hi);
__device__ __forceinline__ unsigned cvt_pk_bf16(float lo, float hi) { return cvt_pk_op(lo, hi); }
__device__ __forceinline__ unsigned cvt_pk_op(float lo, float hi) { const f32x2 v = {lo, hi}; const bf16x2_t b = __builtin_convertvector(v, bf16x2_t); return __builtin_bit_cast(unsigned, b); }

__device__ __forceinline__ void unpack8(const u32x4 r, float (&f)[8]) {
    f[0] = __uint_as_float(r.x << 16); f[1] = __uint_as_float(r.x & 0xffff0000u); f[2] = __uint_as_float(r.y << 16); f[3] = __uint_as_float(r.y & 0xffff0000u);
    f[4] = __uint_as_float(r.z << 16); f[5] = __uint_as_float(r.z & 0xffff0000u); f[6] = __uint_as_float(r.w << 16); f[7] = __uint_as_float(r.w & 0xffff0000u);
}
__device__ __forceinline__ bf16x8 pack8(const float (&f)[8]) {
    u32x4 w; w.x = cvt_pk_op(f[0], f[1]); w.y = cvt_pk_op(f[2], f[3]); w.z = cvt_pk_op(f[4], f[5]); w.w = cvt_pk_op(f[6], f[7]);
    return __builtin_bit_cast(bf16x8, w);
}


typedef int i32x8 __attribute__((ext_vector_type(8)));
constexpr float W8_SCALE = 16.f, ACT8_SCALE = 8.f;
constexpr int E8_ONE = 0x7f7f7f7f, E8_W = 0x7b7b7b7b  , E8_ACT = 0x7c7c7c7c  ;
__device__ __forceinline__ float clamp8(float v) { return fminf(fmaxf(v, -448.f), 448.f); }
__device__ __forceinline__ unsigned pk4_fp8(float a, float b, float c, float d) {
    int w = __builtin_amdgcn_cvt_pk_fp8_f32(clamp8(a), clamp8(b), 0, false);
    w = __builtin_amdgcn_cvt_pk_fp8_f32(clamp8(c), clamp8(d), w, true);
    return (unsigned)w;
}
__device__ __forceinline__ int lds_byte(int r, int c) { const int st = (r >> 4) * 2 + (c >> 5), rr = r & 15, cc = c & 31, ob = rr * 64 + cc * 2; return st * 1024 + (ob ^ (((ob >> 9) & 1) << 5)); }
__device__ __forceinline__ void stage_rc(int b, int& R, int& C) { const int st = b / 1024, sb = b % 1024, swz = sb ^ (((sb >> 9) & 1) << 5); R = (st >> 1) * 16 + swz / 64; C = (st & 1) * 32 + (swz % 64) / 2; }
__device__ __forceinline__ int perm32(int rho) { const int n = rho >> 4, i = rho & 15; return 8 * (i >> 2) + 4 * n + (i & 3); }

__device__ __forceinline__ int tid_of(int swave) { int l; asm volatile("v_mbcnt_lo_u32_b32 %0, -1, 0\n\tv_mbcnt_hi_u32_b32 %0, -1, %0" : "=v"(l)); return swave * 64 + l; }
struct Unit { const char* A; const char* B0; const char* B1; const int* rows; const int* rtok; int pm, pn, aux, nvalid, half; };

struct Args {
    const float* in[20]; float* out; unsigned char* ws; int ph_lo, ph_hi;
};
enum { I_X = 0, I_RELB, I_NMIXG, I_WIN, I_QG, I_KG, I_SINK, I_CONVW, I_CONVB, I_GATEB, I_MNORMG, I_WOUT, I_NFFNG, I_WRG, I_BRG, I_WRE, I_BRE, I_WGATE, I_WUP, I_WDOWN };


template <class Epi, class Sched, bool MOE>
__device__ __forceinline__ void gemm_phase(LAS unsigned char* lds, const int lda, const int ldb, const int nt, const Sched& S, const Epi& E, const int swave) {
    int tid = tid_of(swave); asm volatile("" : "+v"(tid));
    const int wid = __builtin_amdgcn_readfirstlane(tid >> 6), lane = tid & 63, wr = wid >> 2, wc = wid & 3, fr = lane & 15, fq = lane >> 4;
    int Rr[2], Cc[2]; unsigned voffB[2];
#pragma unroll
    for (int i = 0; i < 2; ++i) { int R, C; stage_rc(tid * 16 + i * 8192, R, C); Rr[i] = R; Cc[i] = C; const int Rb = (R & ~31) + perm32(R & 31); voffB[i] = (unsigned)(Rb * ldb + C) * 2u; }
    const size_t kstep = (size_t)(BK * 2);
    const size_t hstepB = (size_t)HALF * ldb * 2, hstepBd = (size_t)HALF * 256 * 2;
    const unsigned ldsw = (unsigned)wid * 1024u;
    const int aoff = lds_byte(wr * 64 + fr, fq * 8), boff = lds_byte(wc * 32 + fr, fq * 8);
#define FK_SA(b, h) (((b) * 2 + (h)) * HTB)
#define FK_SB(b, h) ((4 + (b) * 2 + (h)) * HTB)
#define FK_STAGE(bufoff, gbase, voff) do { _Pragma("unroll") for (int _i = 0; _i < 2; ++_i) \
        __builtin_amdgcn_global_load_lds((const unsigned*)((const char*)(gbase) + (voff)[_i]), (LAS unsigned*)(lds + (bufoff) + ldsw + _i * 8192), 16, 0, 0); } while (0)
#define FK_LDA(dst, b, h) do { _Pragma("unroll") for (int m = 0; m < 4; ++m) _Pragma("unroll") for (int k = 0; k < 2; ++k) dst[m][k] = *(const LAS bf16x8*)(lds + FK_SA(b, h) + aoff + m * 2048 + k * 1024); } while (0)
#define FK_LDB(dst, b, h) do { _Pragma("unroll") for (int n = 0; n < 2; ++n) _Pragma("unroll") for (int k = 0; k < 2; ++k) dst[n][k] = *(const LAS bf16x8*)(lds + FK_SB(b, h) + boff + n * 2048 + k * 1024); } while (0)
#define FK_CAT8(x) __builtin_bit_cast(i32x8, __builtin_shufflevector((x)[0], (x)[1], 0, 1, 2, 3, 4, 5, 6, 7, 8, 9, 10, 11, 12, 13, 14, 15))
#define FK_MMA(ai, bj, At, Bt) do { __builtin_amdgcn_s_setprio(1); _Pragma("unroll") for (int m = 0; m < 4; ++m) _Pragma("unroll") for (int n = 0; n < 2; ++n) { \
        if constexpr (MOE)   \
            { const i32x8 _a8 = FK_CAT8(Bt[n]), _b8 = FK_CAT8(At[m]); asm volatile("v_mfma_scale_f32_16x16x128_f8f6f4 %0, %1, %2, %0, %3, %4 op_sel_hi:[0,0,0]" : "+v"(acc[ai][bj][m][n]) : "v"(_a8), "v"(_b8), "v"(scaleWv), "v"(scaleAv)); } \
        else { _Pragma("unroll") for (int k = 0; k < 2; ++k) acc[ai][bj][m][n] = __builtin_amdgcn_mfma_f32_16x16x32_bf16(Bt[n][k], At[m][k], acc[ai][bj][m][n], 0, 0, 0); } } \
        __builtin_amdgcn_s_setprio(0); } while (0)
#define FK_WAIT_V(n) asm volatile("s_waitcnt vmcnt(" #n ")" ::: "memory")
#define FK_WAIT_L(n) asm volatile("s_waitcnt lgkmcnt(" #n ")" ::: "memory")
#define FK_BAR __builtin_amdgcn_s_barrier()
#define FK_SCHED __builtin_amdgcn_sched_barrier(0)
#define FK_VOFF(u, v) do { _Pragma("unroll") for (int _h = 0; _h < 2; ++_h) _Pragma("unroll") for (int _i = 0; _i < 2; ++_i) { \
        const int _rr = _h * HALF + Rr[_i]; int _row = _rr; \
        if constexpr (MOE) { if ((u).rows) { const int _rc = _rr < (u).nvalid ? _rr : (u).nvalid - 1; _row = __builtin_nontemporal_load((u).rows + _rc); } }     \
        v[_h][_i] = (unsigned)(_row * lda + Cc[_i]) * 2u; \
        asm volatile("" : "+v"(v[_h][_i])); } } while (0)
    Unit cur, nxt; int ui = 0; int pend = -1;
    if (!S.next(0, cur)) return;
    f32x4 acc[2][2][4][2];
#pragma unroll
    for (int a = 0; a < 2; ++a)
#pragma unroll
        for (int b = 0; b < 2; ++b)
#pragma unroll
            for (int m = 0; m < 4; ++m)
#pragma unroll
                for (int n = 0; n < 2; ++n) acc[a][b][m][n] = (f32x4){0.f, 0.f, 0.f, 0.f};
    bf16x8 At[4][2], B0[2][2], B1[2][2];
    unsigned vC[2][2];
    LAS int* rawt = (LAS int*)(lds + MISC_OFF);
    FK_VOFF(cur, vC);
    const char* cA = cur.A;
    LAS float* misc = (LAS float*)(lds + MISC_OFF);
    E.prep_all(S, misc, tid);
    S.a_ready(cur, wid, lane);
    {
        const bool dn = MOE && cur.aux != 0; unsigned vb[2]; const size_t hs = dn ? hstepBd : hstepB;
#pragma unroll
        for (int i = 0; i < 2; ++i) vb[i] = dn ? ((voffB[i] + 2u * (unsigned)Cc[i]) >> 1) : voffB[i];
        FK_STAGE(FK_SB(0, 0), cur.B0, vb); FK_STAGE(FK_SB(0, 1), cur.B0 + hs, vb); FK_STAGE(FK_SA(0, 0), cA, vC[0]); FK_STAGE(FK_SA(0, 1), cA, vC[1]);
        if (wr == 1) FK_BAR;
        FK_WAIT_V(2); FK_BAR;
        FK_STAGE(FK_SB(1, 0), cur.B0 + kstep, vb); FK_STAGE(FK_SA(1, 0), cA + kstep, vC[0]); FK_STAGE(FK_SB(1, 1), cur.B0 + hs + kstep, vb);
        FK_WAIT_V(6); FK_BAR;
    }
    for (;;) {
        const bool has_next = S.next(ui + 1, nxt);
        if constexpr (MOE) {
            if (has_next && nxt.rows) {
#pragma unroll
                for (int h = 0; h < 2; ++h)
#pragma unroll
                    for (int i = 0; i < 2; ++i) { int R_, C_; stage_rc(tid_of(swave) * 16 + i * 8192, R_, C_); const int rr = h * HALF + R_; const int rc = rr < nxt.nvalid ? rr : nxt.nvalid - 1;
                        __builtin_amdgcn_global_load_lds((const unsigned*)(nxt.rows + rc), (LAS unsigned*)(rawt + (h * 2 + i) * 512 + wid * 64), 4, 0, 0); }
            }
        }
        const char* nA = has_next ? nxt.A : cA; const char* nB = has_next ? nxt.B0 : cur.B0;
        const bool do0 = cur.half != 1, do1 = cur.half != 0;
        const int scaleAv = cur.aux ? E8_ACT : E8_ONE, scaleWv = E8_W;
        const bool dnC = MOE && cur.aux != 0, dnN = MOE && (has_next ? nxt.aux != 0 : cur.aux != 0);
        unsigned vN[2][2];
        for (int t = 0; t < nt; t += 2) {
            const bool last = (t == nt - 2);
            const char* a1 = cA + (size_t)(t + 1) * kstep;
            const char* a2 = last ? nA : cA + (size_t)(t + 2) * kstep;
            const char* bseg = (t + 2 < (nt >> 1)) ? cur.B0 : cur.B1;
            const char* b2 = last ? nB : bseg + (size_t)(t + 2) * kstep;
            const char* a3 = a2 + kstep; const char* b3 = b2 + kstep;
            if (last && has_next) S.a_ready(nxt, wid, lane);
            unsigned va2[2][2], vb2[2]; size_t hs2 = hstepB;
            if constexpr (MOE) {
                if (last) {
#pragma unroll
                    for (int h = 0; h < 2; ++h)
#pragma unroll
                        for (int i = 0; i < 2; ++i) {
                            unsigned v = vC[h][i];
                            if (has_next) { const int t3_ = tid_of(swave); int R_, C_; stage_rc(t3_ * 16 + i * 8192, R_, C_); int row = h * HALF + R_; if (nxt.rows) row = rawt[(h * 2 + i) * 512 + t3_]; v = (unsigned)(row * lda + C_) * 2u; }
                            vN[h][i] = v; }
                }
                const bool dn2 = last ? dnN : dnC;
#pragma unroll
                for (int h = 0; h < 2; ++h)
#pragma unroll
                    for (int i = 0; i < 2; ++i) va2[h][i] = last ? vN[h][i] : vC[h][i];
#pragma unroll
                for (int i = 0; i < 2; ++i) { int R_, C_; stage_rc(tid_of(swave) * 16 + i * 8192, R_, C_); vb2[i] = dn2 ? ((voffB[i] + 2u * (unsigned)C_) >> 1) : voffB[i]; }
                hs2 = dn2 ? hstepBd : hstepB;
            } else {
#pragma unroll
                for (int h = 0; h < 2; ++h)
#pragma unroll
                    for (int i = 0; i < 2; ++i) va2[h][i] = vC[h][i];
                vb2[0] = voffB[0]; vb2[1] = voffB[1];
            }
            FK_LDB(B0, 0, 0); FK_LDB(B1, 0, 1); FK_SCHED; FK_LDA(At, 0, 0); FK_STAGE(FK_SA(1, 1), a1, vC[1]);
            FK_WAIT_V(8); FK_WAIT_L(0); FK_BAR; if (do0) { FK_MMA(0, 0, At, B0); FK_MMA(0, 1, At, B1); } FK_BAR; FK_SCHED;
            FK_LDA(At, 0, 1); FK_STAGE(FK_SB(0, 0), b2, vb2); FK_STAGE(FK_SB(0, 1), b2 + hs2, vb2); FK_STAGE(FK_SA(0, 0), a2, va2[0]);
            FK_WAIT_V(8);
            if constexpr (MOE) { if (pend >= 0) { E.publish(pend, lane); pend = -1; } }
            FK_WAIT_L(0); FK_BAR; if (do1) { FK_MMA(1, 0, At, B0); FK_MMA(1, 1, At, B1); } FK_BAR; FK_SCHED;
            FK_LDB(B0, 1, 0); FK_LDB(B1, 1, 1); FK_SCHED; FK_LDA(At, 1, 0); FK_STAGE(FK_SA(0, 1), a2, va2[1]);
            FK_WAIT_V(8); FK_WAIT_L(0); FK_BAR; if (do0) { FK_MMA(0, 0, At, B0); FK_MMA(0, 1, At, B1); } FK_BAR; FK_SCHED;
            FK_LDA(At, 1, 1); FK_STAGE(FK_SB(1, 0), b3, vb2); FK_STAGE(FK_SB(1, 1), b3 + hs2, vb2); FK_STAGE(FK_SA(1, 0), a3, va2[0]);
            FK_WAIT_V(8); FK_WAIT_L(0); FK_BAR; if (do1) { FK_MMA(1, 0, At, B0); FK_MMA(1, 1, At, B1); } FK_BAR; FK_SCHED;
        }
        if constexpr (MOE) asm volatile("s_nop 15\n\ts_nop 15" ::: "memory");
        if (wr == 0) FK_BAR;
        { const int t2_ = tid_of(swave); int fr_ = t2_ & 15, fq_ = (t2_ >> 4) & 3;        if constexpr (MOE) pend = E(acc, cur, ui, misc, wr, wc, fr_, fq_); else E(acc, cur, ui, misc, wr, wc, fr_, fq_); }
        if (!has_next) break;
#pragma unroll
        for (int a = 0; a < 2; ++a)
#pragma unroll
            for (int b = 0; b < 2; ++b)
#pragma unroll
                for (int m = 0; m < 4; ++m)
#pragma unroll
                    for (int n = 0; n < 2; ++n) acc[a][b][m][n] = (f32x4){0.f, 0.f, 0.f, 0.f};
        cur = nxt; cA = nA; ++ui;
        if constexpr (MOE) {
#pragma unroll
            for (int h = 0; h < 2; ++h)
#pragma unroll
                for (int i = 0; i < 2; ++i) vC[h][i] = vN[h][i];
        }
        if (wr == 1) FK_BAR;
    }
    FK_WAIT_V(0);
    if constexpr (MOE) { if (pend >= 0) E.publish(pend, lane); }
    FK_BAR;
#undef FK_SA
#undef FK_SB
#undef FK_STAGE
#undef FK_LDA
#undef FK_LDB
#undef FK_MMA
#undef FK_CAT8
#undef FK_WAIT_V
#undef FK_WAIT_L
#undef FK_BAR
#undef FK_SCHED
#undef FK_VOFF
}

__device__ __forceinline__ bool deal_item(int i, int n, int G, int c, bool split, int& L, int& half) {
    const int rounds = n / G, tail = n - rounds * G;
    half = -1;
    if (i < rounds) { L = i * G + c; return true; }
    if (i > rounds || tail == 0) return false;
    if (split && 2 * tail <= G) { if (c >= 2 * tail) return false; L = rounds * G + (c >> 1); half = c & 1; return true; }
    if (c >= tail) return false;
    L = rounds * G + c; return true;
}
struct DenseOrder {
    int nM, nN, nwg, G, c; const char* A; const char* Bt; size_t tstepA, tstepB;
    __device__ void init(int M, int N, int G_, int c_, const void* A_, int lda, const void* Bt_, int ldb) { nM = M / BM; nN = N / BM; nwg = nM * nN; G = G_; c = c_; A = (const char*)A_; Bt = (const char*)Bt_; tstepA = (size_t)BM * lda * 2; tstepB = (size_t)BM * ldb * 2; }
    __device__ __forceinline__ bool next(int i, Unit& u) const {
        int L, half; if (!deal_item(i, nwg, G, c, false, L, half)) return false;
        int wgid = L; { const int q = nwg / 8, r = nwg % 8, xcd = wgid % 8, off = wgid / 8; wgid = (xcd < r ? xcd * (q + 1) : r * (q + 1) + (xcd - r) * q) + off; }
        const int nig = 8 * nN, gid = wgid / nig, fm = gid * 8, gsz = (nM - fm) < 8 ? (nM - fm) : 8;
        u.pm = fm + ((wgid % nig) % gsz); u.pn = (wgid % nig) / gsz;
        u.A = A + (size_t)u.pm * tstepA; u.B0 = Bt + (size_t)u.pn * tstepB; u.B1 = u.B0; u.rows = nullptr; u.rtok = nullptr; u.aux = 0; u.nvalid = BM; u.half = half; return true;
    }
    __device__ __forceinline__ void a_ready(const Unit&, int, int) const {}
};

struct EpiInProj {
    const float* ssq; bf16_t* proj; float* gates; const float* gate_b;
    template <class Sched> __device__ __forceinline__ void prep_all(const Sched& S, LAS float* misc, int tid) const {
        const int r = tid >> 1; f32x4 s0[4], s1[4]; bool have[4];
#pragma unroll
        for (int i = 0; i < 4; ++i) { Unit u; have[i] = S.next(i, u); const int pm = have[i] ? u.pm : 0;
            const f32x4* sp = (const f32x4*)(ssq + (size_t)(pm * BM + r) * 16 + (tid & 1) * 8); s0[i] = sp[0]; s1[i] = sp[1]; }
#pragma unroll
        for (int i = 0; i < 4; ++i) {
            float ss = ((s0[i][0] + s0[i][1]) + (s0[i][2] + s0[i][3])) + ((s1[i][0] + s1[i][1]) + (s1[i][2] + s1[i][3]));
            ss += __shfl_xor(ss, 1);
            if (have[i] && (tid & 1) == 0) misc[i * 256 + r] = rsqrtf(ss * (1.f / 1024.f) + 1e-6f);
        }
    }
    __device__ __forceinline__ void prep(const Unit&, int, LAS float*, int) const {}
    __device__ __forceinline__ void operator()(const f32x4 (&acc)[2][2][4][2], const Unit& u, int ui, const LAS float* misc, int wr, int wc, int fr, int fq) const {
        const int rl0 = wr * 64 + fr, row0 = u.pm * BM + rl0;
        const LAS float* tab = misc + ui * 256;
#pragma unroll
        for (int ai = 0; ai < 2; ++ai)
#pragma unroll
            for (int m = 0; m < 4; ++m) {
                if (u.half >= 0 && u.half != ai) continue;
                const int row = row0 + ai * HALF + m * 16;
                const float rs = tab[rl0 + ai * HALF + m * 16];
                if (u.pn < 9) {
                    bf16_t* rowp = proj + (size_t)row * NPROJ + u.pn * BM + wc * 32 + 8 * fq;
#pragma unroll
                    for (int bj = 0; bj < 2; ++bj) { const f32x4 v0 = acc[ai][bj][m][0] * rs, v1 = acc[ai][bj][m][1] * rs;
                        u32x4 w; w.x = cvt_pk_bf16(v0[0], v0[1]); w.y = cvt_pk_bf16(v0[2], v0[3]); w.z = cvt_pk_bf16(v1[0], v1[1]); w.w = cvt_pk_bf16(v1[2], v1[3]);
                        *(u32x4*)(rowp + bj * HALF) = w; }
                } else if (wc == 0 && fq == 0) {
                    const f32x4 g0 = *(const f32x4*)(gate_b), g1 = *(const f32x4*)(gate_b + 4);
                    *(f32x4*)(gates + (size_t)row * 8) = acc[ai][0][m][0] * rs + g0;
                    *(f32x4*)(gates + (size_t)row * 8 + 4) = acc[ai][0][m][1] * rs + g1;
                }
            }
    }
};


template <bool INDIRECT, bool FINAL>
struct EpiResid {
    bf16_t* xb; float* out; float* ssq; int dry; unsigned char* xb8;
    template <class Sched> __device__ __forceinline__ void prep_all(const Sched&, LAS float*, int) const {}
    __device__ __forceinline__ void prep(const Unit&, int, LAS float*, int) const {}
    __device__ __forceinline__ void operator()(const f32x4 (&acc)[2][2][4][2], const Unit& u, int ui, const LAS float* misc, int wr, int wc, int fr, int fq) const {
        if (dry) return;
        const int col0 = u.pn * BM + wc * 32 + 8 * fq;
        int tok[2][4];
#pragma unroll
        for (int ai = 0; ai < 2; ++ai)
#pragma unroll
            for (int m = 0; m < 4; ++m) { const int rl = ai * HALF + wr * 64 + m * 16 + fr; if constexpr (INDIRECT) { const int t_ = __builtin_nontemporal_load(u.rtok + (rl < u.nvalid ? rl : u.nvalid - 1)); tok[ai][m] = rl < u.nvalid ? t_ : -1; } else tok[ai][m] = u.pm * BM + rl; }
#pragma unroll
        for (int ai = 0; ai < 2; ++ai) {
            if (u.half >= 0 && u.half != ai) continue;
            u32x4 xr[4][2];
#pragma unroll
            for (int m = 0; m < 4; ++m)
#pragma unroll
                for (int bj = 0; bj < 2; ++bj) { const int tk = tok[ai][m] < 0 ? 0 : tok[ai][m]; xr[m][bj] = *(const u32x4*)(xb + (size_t)tk * D + col0 + bj * HALF); }
#pragma unroll
            for (int m = 0; m < 4; ++m) {
                const int tk = tok[ai][m];
                if (tk >= 0) {
                    const size_t off = (size_t)tk * D + col0;
                    float part = 0.f;
#pragma unroll
                    for (int bj = 0; bj < 2; ++bj) {
                        float x[8]; unpack8(xr[m][bj], x);
                        float h[8];
#pragma unroll
                        for (int j = 0; j < 4; ++j) { h[j] = x[j] + acc[ai][bj][m][0][j]; h[4 + j] = x[4 + j] + acc[ai][bj][m][1][j]; }
#pragma unroll
                        for (int j = 0; j < 8; ++j) part += h[j] * h[j];
                        if constexpr (FINAL) { *(f32x4*)(out + off + bj * HALF) = (f32x4){h[0], h[1], h[2], h[3]}; *(f32x4*)(out + off + bj * HALF + 4) = (f32x4){h[4], h[5], h[6], h[7]}; }
                        else { u32x4 w; w.x = cvt_pk_bf16(h[0], h[1]); w.y = cvt_pk_bf16(h[2], h[3]); w.z = cvt_pk_bf16(h[4], h[5]); w.w = cvt_pk_bf16(h[6], h[7]); *(u32x4*)(xb + off + bj * HALF) = w; }
                        if (xb8) { u32x2 w8; w8.x = pk4_fp8(h[0], h[1], h[2], h[3]); w8.y = pk4_fp8(h[4], h[5], h[6], h[7]); *(u32x2*)(xb8 + off + bj * HALF) = w8; }
                    }
                    if constexpr (!FINAL) {
                        part += __shfl_xor(part, 16); part += __shfl_xor(part, 32);
                        if (fq == 0) ssq[(size_t)tk * 16 + u.pn * 4 + wc] = part;
                    }
                }
            }
        }
    }
};

__device__ __forceinline__ void store16_sc1(void* p, u32x4 v) { asm volatile("global_store_dwordx4 %0, %1, off sc1\n\ts_nop 1" :: "v"(p), "v"(v) : "memory"); }
__device__ __forceinline__ void store8_sc1(void* p, u32x2 v) { asm volatile("global_store_dwordx2 %0, %1, off sc1\n\ts_nop 1" :: "v"(p), "v"(v) : "memory"); }
struct EpiUp {
    bf16_t* act; const float* rw; unsigned* upcnt;
    __device__ __forceinline__ void operator()(const f32x4 (&acc)[2][2][4][2], const Unit& u, int wr, int wc, int fr, int fq) const {
        const int slot = u.pn >> 2, col0 = slot * 512 + (u.pn & 3) * 128 + wc * 32 + 8 * fq;
        int tok[2][4];
#pragma unroll
        for (int ai = 0; ai < 2; ++ai)
#pragma unroll
            for (int m = 0; m < 4; ++m) { const int rl = ai * HALF + wr * 64 + m * 16 + fr; const int t_ = __builtin_nontemporal_load(u.rtok + (rl < u.nvalid ? rl : u.nvalid - 1)); tok[ai][m] = rl < u.nvalid ? t_ : -1; }
        f32x4 wv[2][4];
#pragma unroll
        for (int ai = 0; ai < 2; ++ai)
#pragma unroll
            for (int m = 0; m < 4; ++m) { const f32x4 w_ = __builtin_nontemporal_load((const f32x4*)(rw + (size_t)(tok[ai][m] < 0 ? 0 : tok[ai][m]) * 4)); wv[ai][m] = tok[ai][m] >= 0 ? w_ : (f32x4){0.f, 0.f, 0.f, 0.f}; }
#pragma unroll
        for (int ai = 0; ai < 2; ++ai)
#pragma unroll
            for (int m = 0; m < 4; ++m) {
                if (u.half >= 0 && u.half != ai) continue;
                const int rl = ai * HALF + wr * 64 + m * 16 + fr;
                const float rs = wv[ai][m][2], ws_ = (slot ? wv[ai][m][1] : wv[ai][m][0]) * rs;
                float o[8];
#pragma unroll
                for (int n = 0; n < 2; ++n)
#pragma unroll
                    for (int j = 0; j < 4; ++j) { const float gv = acc[ai][0][m][n][j] * rs, uv = acc[ai][1][m][n][j]; o[n * 4 + j] = gv * __builtin_amdgcn_rcpf(1.f + __expf(-gv)) * uv * ws_; }
                u32x2 pk; pk.x = pk4_fp8(o[0] * ACT8_SCALE, o[1] * ACT8_SCALE, o[2] * ACT8_SCALE, o[3] * ACT8_SCALE); pk.y = pk4_fp8(o[4] * ACT8_SCALE, o[5] * ACT8_SCALE, o[6] * ACT8_SCALE, o[7] * ACT8_SCALE);
                store8_sc1((unsigned char*)act + ((size_t)u.pm * BM + rl) * 1024 + col0, pk);
            }
    }
    __device__ __forceinline__ void publish(int pend, int lane) const { if (lane == 0) __hip_atomic_fetch_add(upcnt + (pend >> 2), (unsigned)(pend & 3), __ATOMIC_RELAXED, __HIP_MEMORY_SCOPE_AGENT); }
};
template <bool FINAL>
struct EpiMoe {
    EpiUp up; EpiResid<true, FINAL> dn;
    template <class Sched> __device__ __forceinline__ void prep_all(const Sched&, LAS float*, int) const {}
    __device__ __forceinline__ void prep(const Unit&, int, LAS float*, int) const {}
    __device__ __forceinline__ int operator()(const f32x4 (&acc)[2][2][4][2], const Unit& u, int ui, const LAS float* misc, int wr, int wc, int fr, int fq) const {
        if (u.aux == 0) {
            up(acc, u, wr, wc, fr, fq);
            asm volatile("s_waitcnt vmcnt(0)" ::: "memory");
            up.publish(u.pm * 4 + (u.half < 0 ? 2 : 1), fq * 16 + fr);
            return -1;
        }
        dn(acc, u, ui, misc, wr, wc, fr, fq); return -1;
    }
    __device__ __forceinline__ void publish(int tile, int lane) const { up.publish(tile, lane); }
};

__device__ __forceinline__ int ld_ctl(const int* p) { return (int)__hip_atomic_load((const unsigned*)p, __ATOMIC_RELAXED, __HIP_MEMORY_SCOPE_AGENT); }
__device__ __forceinline__ void pair_dec(int p, int& lo, int& hi) { lo = (p < 3) ? 0 : ((p < 5) ? 1 : 2); hi = (p < 3) ? p + 1 : ((p < 5) ? p - 1 : 3); }

struct MoeOrder {
    int ntile, G, c, nup8, ndn4;
    int pad_;
    const LAS int* tb; const int* rowtokb; const char* xb; const char* wgu; const char* act; const char* wd; unsigned* upcnt;
    __device__ __forceinline__ bool next(int i, Unit& u) const {
        int L, half = -1; const int kind = nup8 ? 0 : 1;
        if (kind == 0) { if (!deal_item(i, nup8 * 8, G, c, pad_ != 0, L, half)) return false; }
        else {
            const int nd = ndn4 * 4, rup = (ntile * 8) % G, nlight = G - rup; const bool heavy = c < rup;
            int tl = 0, th = 3, base = 0, mine = 0; L = -1;
            for (int r = 0; r < 1024 && base < nd; ++r) {
                const bool toheavy = (rup > 0) && (th + 2 < tl + 2);
                const int gsz = toheavy ? rup : nlight, gidx = toheavy ? c : c - rup;
                if (toheavy == heavy) { if (mine == i) { L = base + gidx; break; } ++mine; }
                if (toheavy) th += 2; else tl += 2;
                base += gsz;
            }
            if (L < 0 || L >= nd) return false;
        }
        const int mt = kind ? (L >> 2) : (L >> 3), pn = kind ? (L & 3) : (L & 7);
        int b = 0;
        for (int j = 1; j < 24; ++j) if (__builtin_amdgcn_readfirstlane(tb[j]) <= mt) b = j;
        const int jl = mt - __builtin_amdgcn_readfirstlane(tb[b]); const int left = __builtin_amdgcn_readfirstlane(tb[32 + b]) - jl * 256;
        const int grp = b / 6; int lo, hi; pair_dec(b % 6, lo, hi);
        u.pm = mt; u.pn = pn; u.aux = kind; u.nvalid = left < 256 ? left : 256; u.half = half;
        u.rtok = rowtokb + (size_t)b * T + jl * 256;
        if (kind == 0) { const int e = grp * 4 + ((pn >> 2) ? hi : lo);
            u.A = xb; u.rows = u.rtok; u.B0 = wgu + ((size_t)e * 1024 + (pn & 3) * 256) * 1024; u.B1 = u.B0; }
        else { u.A = act + (size_t)mt * BM * 1024; u.rows = nullptr;
            u.B0 = wd + ((size_t)(grp * 4 + lo) * 1024 + pn * 256) * 512; u.B1 = wd + ((size_t)(grp * 4 + hi) * 1024 + pn * 256) * 512 - 4 * 128; }
        return true;
    }
    __device__ __forceinline__ void a_ready(const Unit& u, int wid, int lane) const {
        if (u.aux != 0) {
            if (wid == 0) {
                unsigned spins = 0;
                while ((unsigned)__builtin_amdgcn_readfirstlane(__hip_atomic_load(upcnt + u.pm, __ATOMIC_RELAXED, __HIP_MEMORY_SCOPE_AGENT)) < 128u) { __builtin_amdgcn_s_sleep(2); if (++spins > (1u << 22)) break; }
                __builtin_amdgcn_fence(__ATOMIC_ACQUIRE, "agent");
                asm volatile("s_waitcnt vmcnt(0)" ::: "memory");
            }
            asm volatile("" ::: "memory"); __builtin_amdgcn_s_barrier(); asm volatile("" ::: "memory");
        }
    }
};

constexpr int RT_PITCH = 2064;
__device__ __forceinline__ void route1_phase(const Args& a, int l, LAS unsigned char* lds, int bx, int G, int tid) {
    unsigned char* ws = a.ws;
    const int wave = tid >> 6, lane = tid & 63;
    LAS unsigned char* Wt = lds; LAS float* red = (LAS float*)(lds + 48 * RT_PITCH);
    { const u32x4* rt = (const u32x4*)(ws + FW_RT + (size_t)l * 48 * 2048);
      for (int idx = tid; idx < 48 * 128; idx += NTHR) { const int r = idx >> 7, c16 = idx & 127; *(LAS u32x4*)(Wt + r * RT_PITCH + c16 * 16) = __builtin_nontemporal_load(rt + idx); } }
    __syncthreads();
    const bf16_t* hg = (const bf16_t*)(ws + FW_XG); const float* ssq = (const float*)(ws + FW_SSQ);
    float* RW = (float*)(ws + FW_RW); int* ROWTOKB = (int*)(ws + FW_ROWTOKB); unsigned* BCNT = (unsigned*)(ws + FW_CTL) + CW_BCNT + 64 * l;
    for (int slab = bx; slab < 256; slab += G) {
        const int mb = wave & 3, kh = wave >> 2, fr = lane & 15, fq = lane >> 4;
        f32x4 acc[3];
#pragma unroll
        for (int nb = 0; nb < 3; ++nb) acc[nb] = (f32x4){0.f, 0.f, 0.f, 0.f};
        const bf16_t* arow = hg + (size_t)(slab * 64 + mb * 16 + fr) * D + kh * 512 + fq * 8;
        bf16x8 afr[16];
#pragma unroll
        for (int ks = 0; ks < 16; ++ks) afr[ks] = *(const bf16x8*)(arow + ks * 32);
#pragma unroll
        for (int ks = 0; ks < 16; ++ks) {
            const bf16x8 af = afr[ks];
#pragma unroll
            for (int nb = 0; nb < 3; ++nb) {
                const bf16x8 bf = *(const LAS bf16x8*)(Wt + (nb * 16 + fr) * RT_PITCH + (kh * 512 + ks * 32 + fq * 8) * 2);
                acc[nb] = __builtin_amdgcn_mfma_f32_16x16x32_bf16(af, bf, acc[nb], 0, 0, 0);
            }
        }
#pragma unroll
        for (int nb = 0; nb < 3; ++nb)
#pragma unroll
            for (int r = 0; r < 4; ++r) red[(kh * 64 + mb * 16 + fq * 4 + r) * 48 + nb * 16 + fr] = acc[nb][r];
        __syncthreads();
        if (tid < 64) {
            const int t = slab * 64 + tid;
            float lg[20];
#pragma unroll
            for (int j = 0; j < 20; ++j) lg[j] = (red[tid * 48 + j] + red[(64 + tid) * 48 + j]) + (red[tid * 48 + 24 + j] + red[(64 + tid) * 48 + 24 + j]);
            float ss = 0.f;
#pragma unroll
            for (int i = 0; i < 16; ++i) ss += ssq[(size_t)t * 16 + i];
            const float rs = rsqrtf(ss * (1.f / 1024.f) + 1e-6f);
            const float* brg = a.in[I_BRG] + l * 4; const float* bre = a.in[I_BRE] + l * 16;
            float gl[4]; int grp = 0;
#pragma unroll
            for (int j = 0; j < 4; ++j) gl[j] = lg[j] * rs + brg[j];
#pragma unroll
            for (int j = 1; j < 4; ++j) if (gl[j] > gl[grp]) grp = j;
            float gs = 0.f;
#pragma unroll
            for (int j = 0; j < 4; ++j) gs += __expf(gl[j] - gl[grp]);
            const float pg = 1.f / gs;
            float el[4];
#pragma unroll
            for (int j = 0; j < 4; ++j) { float v = 0.f;
#pragma unroll
                for (int q = 0; q < 4; ++q) if (q == grp) v = lg[4 + q * 4 + j] * rs + bre[q * 4 + j];
                el[j] = v; }
            int i0 = 0;
#pragma unroll
            for (int j = 1; j < 4; ++j) if (el[j] > el[i0]) i0 = j;
            int i1 = (i0 == 0) ? 1 : 0;
#pragma unroll
            for (int j = 0; j < 4; ++j) if (j != i0 && el[j] > el[i1]) i1 = j;
            const float w0 = 1.f / (1.f + __expf(el[i1] - el[i0])), w1 = 1.f - w0;
            const int plo = i0 < i1 ? i0 : i1, phi = i0 < i1 ? i1 : i0;
            const float wlo = (i0 < i1 ? w0 : w1) * pg, whi = (i0 < i1 ? w1 : w0) * pg;
            const int pidx = (plo == 0) ? (phi - 1) : ((plo == 1) ? (phi + 1) : 5);
            const int bk = grp * 6 + pidx;
            *(f32x4*)(RW + t * 4) = (f32x4){wlo, whi, rs, 0.f};
            int lpos = 0; unsigned mycnt = 0;
#pragma unroll 1
            for (int b = 0; b < 24; ++b) {
                const unsigned long long mk = __ballot(bk == b);
                if (bk == b) lpos = __popcll(mk & ((1ull << lane) - 1ull));
                if (lane == b) mycnt = (unsigned)__popcll(mk);
            }
            unsigned base = 0;
            if (mycnt > 0) base = __hip_atomic_fetch_add(BCNT + lane, mycnt, __ATOMIC_RELAXED, __HIP_MEMORY_SCOPE_AGENT);
            const int pos = (int)__shfl(base, bk) + lpos;
            ROWTOKB[(size_t)bk * T + pos] = t;
        }
        __syncthreads();
    }
}
__device__ __forceinline__ float ld_f(const float* p) { return __hip_atomic_load(p, __ATOMIC_RELAXED, __HIP_MEMORY_SCOPE_AGENT); }
__device__ __forceinline__ float scan_add(float v, int lane) {
#pragma unroll
    for (int o = 1; o < 64; o <<= 1) { const float y = __int_as_float(__builtin_amdgcn_ds_bpermute(((lane - o) & 63) << 2, __float_as_int(v))); if (lane >= o) v += y; }
    return v;
}
__device__ __forceinline__ float scan_max(float v, int lane) {
#pragma unroll
    for (int o = 1; o < 64; o <<= 1) { const float y = __int_as_float(__builtin_amdgcn_ds_bpermute(((lane - o) & 63) << 2, __float_as_int(v))); if (lane >= o) v = fmaxf(v, y); }
    return v;
}
__device__ __forceinline__ float logsigf(float x) { return fminf(x, 0.f) - log1pf(__expf(-fabsf(x))); }
__device__ __forceinline__ void conv8(const bf16_t* proj, size_t tok, int tpos, const float* cw, const float* cb, int ch, float (&y)[8]) {
    const f32x4 b0 = *(const f32x4*)(cb + ch), b1 = *(const f32x4*)(cb + ch + 4);
#pragma unroll
    for (int j = 0; j < 4; ++j) { y[j] = b0[j]; y[4 + j] = b1[j]; }
#pragma unroll
    for (int j = 0; j < 4; ++j) {
        const int dt = 3 - j;
        if (tpos - dt >= 0) {
            const u32x4 r = *(const u32x4*)(proj + (tok - dt) * NPROJ + 768 + ch);
            float x[8]; unpack8(r, x);
            const f32x4 w0 = *(const f32x4*)(cw + j * 512 + ch), w1 = *(const f32x4*)(cw + j * 512 + ch + 4);
#pragma unroll
            for (int i = 0; i < 4; ++i) { y[i] += w0[i] * x[i]; y[4 + i] += w1[i] * x[4 + i]; }
        }
    }
#pragma unroll
    for (int i = 0; i < 8; ++i) y[i] = y[i] * __builtin_amdgcn_rcpf(1.f + __expf(-y[i]));
}


__device__ __forceinline__ void conv32(const bf16_t* proj, size_t tok, int tpos, const float* cw, const float* cb, int ch, float (&y)[32]) {
    u32x4 r[4][4];
#pragma unroll
    for (int j = 0; j < 4; ++j) {
        const int dt = 3 - j;
#pragma unroll
        for (int i = 0; i < 4; ++i) r[j][i] = (tpos - dt >= 0) ? *(const u32x4*)(proj + (tok - dt) * NPROJ + 768 + ch + i * 8) : (u32x4){0u, 0u, 0u, 0u};
    }
#pragma unroll
    for (int i = 0; i < 8; ++i) { const f32x4 b4 = *(const f32x4*)(cb + ch + i * 4);
#pragma unroll
        for (int e = 0; e < 4; ++e) y[i * 4 + e] = b4[e]; }
#pragma unroll
    for (int j = 0; j < 4; ++j)
#pragma unroll
        for (int i = 0; i < 4; ++i) {
            float x[8]; unpack8(r[j][i], x);
            const f32x4 w0 = *(const f32x4*)(cw + j * 512 + ch + i * 8), w1 = *(const f32x4*)(cw + j * 512 + ch + i * 8 + 4);
#pragma unroll
            for (int e = 0; e < 4; ++e) { y[i * 8 + e] += w0[e] * x[e]; y[i * 8 + 4 + e] += w1[e] * x[4 + e]; }
        }
#pragma unroll
    for (int i = 0; i < 32; ++i) y[i] = y[i] * __builtin_amdgcn_rcpf(1.f + __expf(-y[i]));
}

constexpr int KS_PITCH = 144, VT_PITCH = 528;
constexpr int AT_KS = 0, AT_VT = 256 * KS_PITCH, AT_BT = AT_VT + 64 * VT_PITCH;
__device__ __forceinline__ void attn_unit(const Args& a, const int l, LAS unsigned char* lds, const int unit, const int tid) {
    const bf16_t* proj = (const bf16_t*)(a.ws + FW_PROJ); bf16_t* mix = (bf16_t*)(a.ws + FW_MIX);
    const int wave = tid >> 6, lane = tid & 63, c = lane & 15, q = lane >> 4;
    const int b = unit >> 6, n = (unit >> 1) & 31, kvh = unit & 1;
    const size_t tok0 = (size_t)b * SEQ + n * 128;
    const int g = wave >> 1, rh = wave & 1, head = kvh * 4 + g;
    u32x4 qraw[4][2];
#pragma unroll
    for (int i = 0; i < 4; ++i)
#pragma unroll
        for (int ks = 0; ks < 2; ++ks) qraw[i][ks] = *(const u32x4*)(proj + (tok0 + (rh * 4 + i) * 16 + c) * NPROJ + head * 64 + ks * 32 + q * 8);
    {
        const int key = tid >> 1, half = tid & 1;
        const bool valid = (n > 0) || (key >= 128);
        const bf16_t* rowp = proj + (tok0 + key - 128) * NPROJ;
        u32x4 kr[4], vr[4];
#pragma unroll
        for (int i = 0; i < 4; ++i) { kr[i] = (u32x4){0u, 0u, 0u, 0u}; vr[i] = kr[i]; }
        if (valid) {
#pragma unroll
            for (int i = 0; i < 4; ++i) { kr[i] = *(const u32x4*)(rowp + 512 + kvh * 64 + half * 32 + i * 8); vr[i] = *(const u32x4*)(rowp + 640 + kvh * 64 + half * 32 + i * 8); }
        }
        float kf[4][8]; float ss = 0.f;
#pragma unroll
        for (int i = 0; i < 4; ++i) { unpack8(kr[i], kf[i]);
#pragma unroll
            for (int j = 0; j < 8; ++j) ss += kf[i][j] * kf[i][j]; }
        ss += __shfl_xor(ss, 1);
        const float rs = rsqrtf(ss * (1.f / 64.f) + 1e-6f);
        const float* kg = a.in[I_KG] + l * 64 + half * 32;
#pragma unroll
        for (int i = 0; i < 4; ++i) {
#pragma unroll
            for (int j = 0; j < 8; ++j) kf[i][j] *= rs * kg[i * 8 + j];
            *(LAS bf16x8*)(lds + AT_KS + key * KS_PITCH + half * 64 + i * 16) = pack8(kf[i]);
        }
#pragma unroll
        for (int i = 0; i < 4; ++i) {
            const unsigned w4[4] = {vr[i].x, vr[i].y, vr[i].z, vr[i].w};
#pragma unroll
            for (int j = 0; j < 4; ++j) {
                *(LAS bf16_t*)(lds + AT_VT + (half * 32 + i * 8 + 2 * j) * VT_PITCH + key * 2) = (bf16_t)(w4[j] & 0xffffu);
                *(LAS bf16_t*)(lds + AT_VT + (half * 32 + i * 8 + 2 * j + 1) * VT_PITCH + key * 2) = (bf16_t)(w4[j] >> 16);
            }
        }
        const int h4 = tid >> 7, dist = tid & 127;
        LAS float* bt = (LAS float*)(lds + AT_BT) + h4 * 384;
        bt[128 + dist] = a.in[I_RELB][t5_bucket(dist) * 8 + kvh * 4 + h4] * 1.4426950408889634f;
        bt[dist] = -INFINITY; bt[256 + dist] = -INFINITY;
    }
    __syncthreads();
    const float sink = a.in[I_SINK][l * 8 + head] * 1.4426950408889634f;
    const float* qg = a.in[I_QG] + l * 64;
    const LAS float* btab = (const LAS float*)(lds + AT_BT) + g * 384;
#pragma unroll 1
    for (int i = 0; i < 4; ++i) {
        const int tb = rh * 4 + i, tt = tb * 16 + c;
        const size_t tq = tok0 + tt;
        bf16x8 qf[2];
        {
            float qv[2][8]; float ss = 0.f;
#pragma unroll
            for (int ks = 0; ks < 2; ++ks) { unpack8(qraw[0][ks], qv[ks]);
#pragma unroll
                for (int j = 0; j < 8; ++j) ss += qv[ks][j] * qv[ks][j]; }
            ss += __shfl_xor(ss, 16); ss += __shfl_xor(ss, 32);
            const float rs = rsqrtf(ss * (1.f / 64.f) + 1e-6f) * (0.125f * 1.4426950408889634f);
#pragma unroll
            for (int ks = 0; ks < 2; ++ks) {
#pragma unroll
                for (int j = 0; j < 8; ++j) qv[ks][j] *= rs * qg[ks * 32 + q * 8 + j];
                qf[ks] = pack8(qv[ks]); }
#pragma unroll
            for (int j = 0; j < 3; ++j) { qraw[j][0] = qraw[j + 1][0]; qraw[j][1] = qraw[j + 1][1]; }
        }
        const int sb0 = tb & ~1;
        f32x4 acc[10];
#pragma unroll
        for (int x = 0; x < 10; ++x) {
            acc[x] = (f32x4){0.f, 0.f, 0.f, 0.f};
#pragma unroll
            for (int ks = 0; ks < 2; ++ks) { const bf16x8 kf = *(const LAS bf16x8*)(lds + AT_KS + ((sb0 + x) * 16 + c) * KS_PITCH + ks * 64 + q * 16);
                acc[x] = __builtin_amdgcn_mfma_f32_16x16x32_bf16(kf, qf[ks], acc[x], 0, 0, 0); }
        }
        float m = -INFINITY;
        const LAS float* bp = btab + (128 + tt + 128 - sb0 * 16 - 4 * q);
#pragma unroll
        for (int x = 0; x < 10; ++x)
#pragma unroll
            for (int r = 0; r < 4; ++r) { const float lg = acc[x][r] + bp[-(x * 16 + r)]; acc[x][r] = lg; }
        if (n == 0) {
#pragma unroll
            for (int x = 0; x < 10; ++x)
#pragma unroll
                for (int r = 0; r < 4; ++r) { const int kk = (sb0 + x) * 16 + 4 * q + r; if (kk < 128) acc[x][r] = -INFINITY; }
        }
#pragma unroll
        for (int x = 0; x < 10; ++x)
#pragma unroll
            for (int r = 0; r < 4; ++r) m = fmaxf(m, acc[x][r]);
        m = fmaxf(m, __shfl_xor(m, 16)); m = fmaxf(m, __shfl_xor(m, 32)); m = fmaxf(m, sink);
        float sum = 0.f;
#pragma unroll
        for (int x = 0; x < 10; ++x)
#pragma unroll
            for (int r = 0; r < 4; ++r) { const float p = __builtin_amdgcn_exp2f(acc[x][r] - m); acc[x][r] = p; sum += p; }
        sum += __shfl_xor(sum, 16); sum += __shfl_xor(sum, 32);
        const float inv = 1.f / (sum + __builtin_amdgcn_exp2f(sink - m));
        bf16x8 pf[5];
#pragma unroll
        for (int kp = 0; kp < 5; ++kp) { float f[8];
#pragma unroll
            for (int r = 0; r < 4; ++r) { f[r] = acc[2 * kp][r] * inv; f[4 + r] = acc[2 * kp + 1][r] * inv; }
            pf[kp] = pack8(f); }
#pragma unroll
        for (int db = 0; db < 4; ++db) {
            f32x4 o = (f32x4){0.f, 0.f, 0.f, 0.f};
#pragma unroll
            for (int kp = 0; kp < 5; ++kp) {
                const LAS unsigned char* vp = lds + AT_VT + (db * 16 + c) * VT_PITCH + (sb0 * 16 + 32 * kp + 4 * q) * 2;
                const u32x2 lo = *(const LAS u32x2*)vp, hi = *(const LAS u32x2*)(vp + 32);
                const u32x4 vv = (u32x4){lo.x, lo.y, hi.x, hi.y};
                o = __builtin_amdgcn_mfma_f32_16x16x32_bf16(__builtin_bit_cast(bf16x8, vv), pf[kp], o, 0, 0, 0);
            }
            u32x2 w; w.x = cvt_pk_bf16(o[0], o[1]); w.y = cvt_pk_bf16(o[2], o[3]);
            *(u32x2*)(mix + tq * D + head * 64 + db * 16 + 4 * q) = w;
        }
    }
    __syncthreads();
}

constexpr int ML_PITCH = 144;
constexpr int MA_VT = 0, MA_KT = 4 * 128 * ML_PITCH, MA_W = MA_KT + 4 * 64 * ML_PITCH;
__device__ __forceinline__ void stage_vt(const bf16_t* proj, size_t t0, LAS unsigned char* vt, int tid) {
    const int s = tid & 63, vg = tid >> 6;
    const bf16_t* rowp = proj + (t0 + s) * NPROJ + 1280 + vg * 64;
#pragma unroll
    for (int i = 0; i < 8; ++i) {
        const u32x4 r = *(const u32x4*)(rowp + i * 8);
        const unsigned w4[4] = {r.x, r.y, r.z, r.w};
#pragma unroll
        for (int j = 0; j < 4; ++j) {
            *(LAS bf16_t*)(vt + (vg * 64 + i * 8 + 2 * j) * ML_PITCH + s * 2) = (bf16_t)(w4[j] & 0xffffu);
            *(LAS bf16_t*)(vt + (vg * 64 + i * 8 + 2 * j + 1) * ML_PITCH + s * 2) = (bf16_t)(w4[j] >> 16);
        }
    }
}
__device__ __forceinline__ void mlstm_a_unit(const Args& a, const int l, LAS unsigned char* lds, const int unit, const int tid) {
    const bf16_t* proj = (const bf16_t*)(a.ws + FW_PROJ); const float* gates = (const float*)(a.ws + FW_GATES);
    const int wave = tid >> 6, lane = tid & 63, c = lane & 15, q = lane >> 4;
    const int b = unit >> 6, ck = unit & 63;
    const size_t t0 = (size_t)b * SEQ + ck * 64;
    LAS float* wS = (LAS float*)(lds + MA_W);
    if (wave < 4) {
        const int h = wave; const size_t t = t0 + lane;
        const float li = gates[t * 8 + h], lf = logsigf(gates[t * 8 + 4 + h]);
        const float bc = scan_add(lf, lane), blast = __shfl(bc, 63);
        const float logw = blast - bc + li, ac = wave_max(logw);
        wS[h * 64 + lane] = __expf(logw - ac);
        if (lane == 0) { float* sc = (float*)(a.ws + FW_SC) + ((size_t)(b * 4 + h) * 64 + ck) * 2; sc[0] = blast; sc[1] = ac; }
    }
    __syncthreads();
    {
        const int s = tid & 63, cg = tid >> 6, head = cg >> 1;
        const float wv = wS[head * 64 + s] * 0.125f;
        const float* cw = a.in[I_CONVW] + l * 2048; const float* cb = a.in[I_CONVB] + l * 512;
        float y[32];
        conv32(proj, t0 + s, ck * 64 + s, cw, cb, 256 + cg * 32, y);
#pragma unroll
        for (int j = 0; j < 32; ++j) *(LAS bf16_t*)(lds + MA_KT + (cg * 32 + j) * ML_PITCH + s * 2) = f2bf(y[j] * wv);
        stage_vt(proj, t0, lds + MA_VT, tid);
    }
    __syncthreads();
    {
        const int head = wave >> 1, vh = wave & 1, bh = b * 4 + head;
        f32x4 acc[4][4];
#pragma unroll
        for (int db = 0; db < 4; ++db)
#pragma unroll
            for (int vb = 0; vb < 4; ++vb) acc[db][vb] = (f32x4){0.f, 0.f, 0.f, 0.f};
#pragma unroll
        for (int ks = 0; ks < 2; ++ks) {
            bf16x8 vf[4];
#pragma unroll
            for (int vb = 0; vb < 4; ++vb) vf[vb] = *(const LAS bf16x8*)(lds + MA_VT + (head * 128 + vh * 64 + vb * 16 + c) * ML_PITCH + ks * 64 + q * 16);
#pragma unroll
            for (int db = 0; db < 4; ++db) {
                const bf16x8 kf = *(const LAS bf16x8*)(lds + MA_KT + (head * 64 + db * 16 + c) * ML_PITCH + ks * 64 + q * 16);
#pragma unroll
                for (int vb = 0; vb < 4; ++vb) acc[db][vb] = __builtin_amdgcn_mfma_f32_16x16x32_bf16(kf, vf[vb], acc[db][vb], 0, 0, 0);
            }
        }
        bf16_t* U = (bf16_t*)((unsigned char*)a.out + OUT_USTATE) + ((size_t)bh * 64 + ck) * 8192;
#pragma unroll
        for (int db = 0; db < 4; ++db)
#pragma unroll
            for (int vb = 0; vb < 4; ++vb) { u32x2 w; w.x = cvt_pk_bf16(acc[db][vb][0], acc[db][vb][1]); w.y = cvt_pk_bf16(acc[db][vb][2], acc[db][vb][3]);
                *(u32x2*)(U + (vh * 64 + vb * 16 + c) * 64 + db * 16 + 4 * q) = w; }
        if (vh == 0) {
            float nn = 0.f; const LAS bf16_t* kr = (const LAS bf16_t*)(lds + MA_KT + (head * 64 + lane) * ML_PITCH);
            for (int s = 0; s < 64; ++s) nn += bf2f(kr[s]);
            ((float*)(a.ws + FW_NIN))[((size_t)bh * 64 + ck) * 64 + lane] = nn;
        }
    }
    __syncthreads();
}
__device__ __forceinline__ void mlstm_scan_item(const Args& a, LAS unsigned char* lds, const int item, const int tid) {
    const int bh = item >> 4, slice = item & 15, elem = slice * 512 + tid;
    LAS float* scs = (LAS float*)lds;
    if (tid < 128) scs[tid] = ld_f((const float*)(a.ws + FW_SC) + (size_t)bh * 128 + tid);
    __syncthreads();
    const bf16_t* U = (const bf16_t*)((const unsigned char*)a.out + OUT_USTATE) + (size_t)bh * 64 * 8192 + elem;
    bf16_t* Cst = (bf16_t*)((unsigned char*)a.out + OUT_CSTATE) + (size_t)bh * 64 * 8192 + elem;
    const float* nin = (const float*)(a.ws + FW_NIN) + (size_t)bh * 64 * 64 + tid; float* nst = (float*)(a.ws + FW_NST) + (size_t)bh * 64 * 64 + tid;
    float* mst = (float*)(a.ws + FW_MST) + bh * 64;
    const bool do_n = (slice == 0) && (tid < 64);
    float m = 0.f, C = 0.f, nv = 0.f;
    {
        float u[64], un[64];
#pragma unroll
        for (int j = 0; j < 64; ++j) { u[j] = bf2f(__builtin_nontemporal_load(U + (size_t)j * 8192)); un[j] = do_n ? __builtin_nontemporal_load(nin + j * 64) : 0.f; }
#pragma unroll
        for (int j = 0; j < 64; ++j) {
            const int ck = j; const float blast = scs[ck * 2], ac = scs[ck * 2 + 1];
            const float mn = fmaxf(blast + m, ac), dec = __expf(blast + m - mn), sc = __expf(ac - mn);
            Cst[(size_t)ck * 8192] = f2bf(C);
            if (do_n) nst[ck * 64] = nv;
            if (slice == 0 && tid == 0) mst[ck] = m;
            C = dec * C + sc * u[j]; nv = dec * nv + sc * un[j]; m = mn;
        }
    }
    __syncthreads();
}
constexpr int MC_KS = 0, MC_VT = 4 * 64 * ML_PITCH, MC_TAB = MC_VT + 4 * 128 * ML_PITCH;
__device__ __forceinline__ void mlstm_c_unit(const Args& a, const int l, LAS unsigned char* lds, const int unit, const int tid) {
    const bf16_t* proj = (const bf16_t*)(a.ws + FW_PROJ); const float* gates = (const float*)(a.ws + FW_GATES); bf16_t* mix = (bf16_t*)(a.ws + FW_MIX);
    const int wave = tid >> 6, lane = tid & 63, c = lane & 15, q = lane >> 4;
    const int b = unit >> 6, ck = unit & 63;
    const size_t t0 = (size_t)b * SEQ + ck * 64;
    const float* cw = a.in[I_CONVW] + l * 2048; const float* cb = a.in[I_CONVB] + l * 512;
    const int head = wave >> 1, th = wave & 1, bh = b * 4 + head;
    LAS float* tabB = (LAS float*)(lds + MC_TAB) + wave * 192; LAS float* tabG = tabB + 64; LAS float* tabM = tabB + 128;
    const float mc = ld_f((const float*)(a.ws + FW_MST) + bh * 64 + ck);
    {
        const size_t t = t0 + lane;
        const float li = gates[t * 8 + head], lf = logsigf(gates[t * 8 + 4 + head]);
        const float bc = scan_add(lf, lane), gg = li - bc, G = scan_max(gg, lane);
        tabB[lane] = bc; tabG[lane] = gg; tabM[lane] = fmaxf(mc, G);
    }
    const float* nst = (const float*)(a.ws + FW_NST) + ((size_t)bh * 64 + ck) * 64;
    f32x4 nv[2][2];
#pragma unroll
    for (int ks = 0; ks < 2; ++ks) { nv[ks][0] = __builtin_nontemporal_load((const f32x4*)(nst + ks * 32 + q * 8)); nv[ks][1] = __builtin_nontemporal_load((const f32x4*)(nst + ks * 32 + q * 8 + 4)); }
    bf16x8 qf[2][2]; float nq[2];
#pragma unroll
    for (int ti = 0; ti < 2; ++ti) {
        const int t = (th * 2 + ti) * 16 + c; float part = 0.f;
#pragma unroll
        for (int ks = 0; ks < 2; ++ks) { float y[8]; conv8(proj, t0 + t, ck * 64 + t, cw, cb, head * 64 + ks * 32 + q * 8, y);
#pragma unroll
            for (int j = 0; j < 4; ++j) part += y[j] * nv[ks][0][j] + y[4 + j] * nv[ks][1][j];
            qf[ti][ks] = pack8(y); }
        part += __shfl_xor(part, 16); part += __shfl_xor(part, 32); nq[ti] = part;
        asm volatile("" ::: "memory");
    }
    const bf16_t* Cst = (const bf16_t*)((const unsigned char*)a.out + OUT_CSTATE) + ((size_t)bh * 64 + ck) * 8192;
    {
        const int s = tid & 63, cg = tid >> 6;
        float y[32];
        conv32(proj, t0 + s, ck * 64 + s, cw, cb, 256 + cg * 32, y);
#pragma unroll
        for (int i = 0; i < 4; ++i) { float z[8];
#pragma unroll
            for (int j = 0; j < 8; ++j) z[j] = y[i * 8 + j] * 0.125f;
            *(LAS bf16x8*)(lds + MC_KS + ((cg >> 1) * 64 + s) * ML_PITCH + ((cg & 1) * 32 + i * 8) * 2) = pack8(z); }
        stage_vt(proj, t0, lds + MC_VT, tid);
    }
    u32x4 cfr[8][2];
#pragma unroll
    for (int vb = 0; vb < 8; ++vb)
#pragma unroll
        for (int ks = 0; ks < 2; ++ks) cfr[vb][ks] = __builtin_nontemporal_load((const u32x4*)(Cst + (vb * 16 + c) * 64 + ks * 32 + q * 8));
    __syncthreads();
    int c2 = c, q2 = q; asm volatile("" : "+v"(c2), "+v"(q2));
    f32x4 as[4][2];
#pragma unroll
    for (int sb = 0; sb < 4; ++sb)
#pragma unroll
        for (int ti = 0; ti < 2; ++ti) {
            as[sb][ti] = (f32x4){0.f, 0.f, 0.f, 0.f};
#pragma unroll
            for (int ks = 0; ks < 2; ++ks) { const bf16x8 kf = *(const LAS bf16x8*)(lds + MC_KS + (head * 64 + sb * 16 + c2) * ML_PITCH + ks * 64 + q2 * 16);
                as[sb][ti] = __builtin_amdgcn_mfma_f32_16x16x32_bf16(kf, qf[ti][ks], as[sb][ti], 0, 0, 0); }
        }
    float Mt[2], isc[2], rsum[2], bt[2];
#pragma unroll
    for (int ti = 0; ti < 2; ++ti) { const int t = (th * 2 + ti) * 16 + c2; Mt[ti] = tabM[t]; bt[ti] = tabB[t]; isc[ti] = __expf(mc - Mt[ti]); rsum[ti] = 0.f; }
#pragma unroll
    for (int sb = 0; sb < 4; ++sb)
#pragma unroll
        for (int r = 0; r < 4; ++r) { const int s = sb * 16 + 4 * q2 + r; const float gs = tabG[s];
#pragma unroll
            for (int ti = 0; ti < 2; ++ti) { const int t = (th * 2 + ti) * 16 + c2; const float dv = (s <= t) ? __expf(gs - Mt[ti]) : 0.f; const float v = as[sb][ti][r] * dv; as[sb][ti][r] = v; rsum[ti] += v; } }
    bf16x8 sf[2][2];
#pragma unroll
    for (int ti = 0; ti < 2; ++ti) { rsum[ti] += __shfl_xor(rsum[ti], 16); rsum[ti] += __shfl_xor(rsum[ti], 32);
#pragma unroll
        for (int kp = 0; kp < 2; ++kp) { float f[8];
#pragma unroll
            for (int r = 0; r < 4; ++r) { f[r] = as[2 * kp][ti][r]; f[4 + r] = as[2 * kp + 1][ti][r]; }
            sf[ti][kp] = pack8(f); } }
    f32x4 an[8][2];
#pragma unroll
    for (int vb = 0; vb < 8; ++vb) {
        an[vb][0] = (f32x4){0.f, 0.f, 0.f, 0.f}; an[vb][1] = an[vb][0];
#pragma unroll
        for (int ks = 0; ks < 2; ++ks) { const bf16x8 cf = __builtin_bit_cast(bf16x8, cfr[vb][ks]);
#pragma unroll
            for (int ti = 0; ti < 2; ++ti) an[vb][ti] = __builtin_amdgcn_mfma_f32_16x16x32_bf16(cf, qf[ti][ks], an[vb][ti], 0, 0, 0); }
#pragma unroll
        for (int ti = 0; ti < 2; ++ti) an[vb][ti] = an[vb][ti] * isc[ti];
#pragma unroll
        for (int kp = 0; kp < 2; ++kp) {
            const LAS unsigned char* vp = lds + MC_VT + (head * 128 + vb * 16 + c2) * ML_PITCH + (32 * kp + 4 * q2) * 2;
            const u32x2 lo = *(const LAS u32x2*)vp, hi = *(const LAS u32x2*)(vp + 32);
            const bf16x8 vf = __builtin_bit_cast(bf16x8, ((u32x4){lo.x, lo.y, hi.x, hi.y}));
#pragma unroll
            for (int ti = 0; ti < 2; ++ti) an[vb][ti] = __builtin_amdgcn_mfma_f32_16x16x32_bf16(vf, sf[ti][kp], an[vb][ti], 0, 0, 0);
        }
    }
    const float* mg = a.in[I_MNORMG] + l * 512 + head * 128;
#pragma unroll
    for (int ti = 0; ti < 2; ++ti) {
        const int t = (th * 2 + ti) * 16 + c2; const size_t tok = t0 + t;
        u32x2 orw[8];
#pragma unroll
        for (int vb = 0; vb < 8; ++vb) orw[vb] = *(const u32x2*)(proj + tok * NPROJ + 1792 + head * 128 + vb * 16 + 4 * q2);
        const float den = isc[ti] * nq[ti] + rsum[ti], dn = 1.f / fmaxf(fabsf(den), __expf(-(bt[ti] + Mt[ti])));
        float ss = 0.f;
#pragma unroll
        for (int vb = 0; vb < 8; ++vb) { an[vb][ti] = an[vb][ti] * dn; ss += (an[vb][ti][0] * an[vb][ti][0] + an[vb][ti][1] * an[vb][ti][1]) + (an[vb][ti][2] * an[vb][ti][2] + an[vb][ti][3] * an[vb][ti][3]); }
        ss += __shfl_xor(ss, 16); ss += __shfl_xor(ss, 32);
        const float rs = rsqrtf(ss * (1.f / 128.f) + 1e-6f);
#pragma unroll
        for (int vb = 0; vb < 8; ++vb) {
            const int v0 = vb * 16 + 4 * q2;
            const float o4[4] = {__uint_as_float(orw[vb].x << 16), __uint_as_float(orw[vb].x & 0xffff0000u), __uint_as_float(orw[vb].y << 16), __uint_as_float(orw[vb].y & 0xffff0000u)};
            const f32x4 g4 = *(const f32x4*)(mg + v0);
            float r4[4];
#pragma unroll
            for (int j = 0; j < 4; ++j) r4[j] = an[vb][ti][j] * rs * g4[j] * __builtin_amdgcn_rcpf(1.f + __expf(-o4[j]));
            u32x2 w; w.x = cvt_pk_bf16(r4[0], r4[1]); w.y = cvt_pk_bf16(r4[2], r4[3]);
            *(u32x2*)(mix + tok * D + 512 + head * 128 + v0) = w;
        }
    }
    __syncthreads();
}

template <bool FP8>
__device__ __forceinline__ void tr_item(const float* W, int ldw, int nvalid, int k0, int n0, void* dstv, int dpitch, int drow0, LAS float* scr, int lane, const float* gk) {
    const int nn = n0 + (lane & 31);
    const float* wp = W + (size_t)(k0 + (lane >> 5)) * ldw + nn;
    float v[32];
    if (nn < nvalid) {
#pragma unroll
        for (int i = 0; i < 32; ++i) v[i] = __builtin_nontemporal_load(wp + (size_t)(2 * i) * ldw);
    } else {
#pragma unroll
        for (int i = 0; i < 32; ++i) v[i] = 0.f;
    }
    const int c = lane & 7;
    f32x4 g0 = (f32x4){1.f, 1.f, 1.f, 1.f}, g1 = g0;
    if (gk) { g0 = *(const f32x4*)(gk + k0 + 8 * c); g1 = *(const f32x4*)(gk + k0 + 8 * c + 4); }
#pragma unroll
    for (int i = 0; i < 32; ++i) scr[(2 * i + (lane >> 5)) * 33 + (lane & 31)] = v[i];
    asm volatile("s_waitcnt lgkmcnt(0)" ::: "memory");
#pragma unroll
    for (int j = 0; j < 4; ++j) { const int n = (lane >> 3) + 8 * j; const LAS float* s = scr + (8 * c) * 33 + n;
        if constexpr (FP8) {
            u32x2 o; o.x = pk4_fp8(s[0 * 33] * g0[0] * W8_SCALE, s[1 * 33] * g0[1] * W8_SCALE, s[2 * 33] * g0[2] * W8_SCALE, s[3 * 33] * g0[3] * W8_SCALE);
            o.y = pk4_fp8(s[4 * 33] * g1[0] * W8_SCALE, s[5 * 33] * g1[1] * W8_SCALE, s[6 * 33] * g1[2] * W8_SCALE, s[7 * 33] * g1[3] * W8_SCALE);
            *(u32x2*)((unsigned char*)dstv + (size_t)(drow0 + n) * dpitch + k0 + 8 * c) = o;
        } else {
            u32x4 o; o.x = pk2(s[0 * 33] * g0[0], s[1 * 33] * g0[1]); o.y = pk2(s[2 * 33] * g0[2], s[3 * 33] * g0[3]); o.z = pk2(s[4 * 33] * g1[0], s[5 * 33] * g1[1]); o.w = pk2(s[6 * 33] * g1[2], s[7 * 33] * g1[3]);
            *(u32x4*)((bf16_t*)dstv + (size_t)(drow0 + n) * dpitch + k0 + 8 * c) = o; } }
    asm volatile("s_waitcnt lgkmcnt(0)" ::: "memory");
}
__device__ __forceinline__ void norm_row(const float* xrow, bf16_t* orow, float* ssqrow, int lane) {
    const f32x4* xr = (const f32x4*)xrow + lane;
    f32x4 v[4]; float s = 0.f;
#pragma unroll
    for (int j = 0; j < 4; ++j) { v[j] = xr[64 * j]; s += (v[j][0] * v[j][0] + v[j][1] * v[j][1]) + (v[j][2] * v[j][2] + v[j][3] * v[j][3]); }
    s = wave_sum(s);
    u32x2* o8 = (u32x2*)orow + lane;
#pragma unroll
    for (int j = 0; j < 4; ++j) { u32x2 w; w.x = pk2(v[j][0], v[j][1]); w.y = pk2(v[j][2], v[j][3]); o8[64 * j] = w; }
    if (lane < 16) ssqrow[lane] = (lane == 0) ? s : 0.f;
}

constexpr int CV_IN = 16 * 80, CV_OUT = 16 * 32, CV_G = 16 * 16 * 16, CV_D = 16 * 8 * 32, CV_LAYER = CV_IN + CV_OUT + 2 * CV_G + CV_D;
__device__ __forceinline__ void conv_item(const Args& a, int it, LAS float* scr, int lane) {
    unsigned char* ws = a.ws;
    const int l = it / CV_LAYER; int r = it % CV_LAYER;
    if (r < CV_IN) { const int kb = r / 80, nb = r % 80;
        tr_item<false>(a.in[I_WIN] + (size_t)l * D * NIN, NIN, NIN, kb * 64, nb * 32, (bf16_t*)(ws + FW_WIN) + (size_t)l * WIN_ROWS * 1024, 1024, nb * 32, scr, lane, a.in[I_NMIXG] + l * D); return; }
    r -= CV_IN;
    if (r < CV_OUT) { const int kb = r / 32, nb = r % 32;
        tr_item<false>(a.in[I_WOUT] + (size_t)l * D * D, D, D, kb * 64, nb * 32, (bf16_t*)(ws + FW_WOUT) + (size_t)l * 1024 * 1024, 1024, nb * 32, scr, lane, nullptr); return; }
    r -= CV_OUT;
    if (r < 2 * CV_G) { const int up = r / CV_G; r %= CV_G; const int e = r / 256, kb = (r % 256) / 16, nb = r % 16, n0 = nb * 32;
        const float* src = a.in[up ? I_WUP : I_WGATE] + ((size_t)l * 16 + e) * 1024 * 512;
        tr_item<true>(src, 512, 512, kb * 64, n0, ws + FW_WGU + ((size_t)l * 16 + e) * 1024 * 1024, 1024, 256 * (n0 / 128) + (n0 % 128) + (up ? 128 : 0), scr, lane, a.in[I_NFFNG] + l * D); return; }
    r -= 2 * CV_G;
    { const int e = r / 256, kb = (r % 256) / 32, nb = r % 32;
        tr_item<true>(a.in[I_WDOWN] + ((size_t)l * 16 + e) * 512 * 1024, 1024, 1024, kb * 64, nb * 32, ws + FW_WD + ((size_t)l * 16 + e) * 1024 * 512, 512, nb * 32, scr, lane, nullptr); }
}
__device__ __forceinline__ void conv_work(const Args& a, LAS unsigned char* lds, int begin, int end, int qword, int tid) {
    unsigned* counter = (unsigned*)(a.ws + FW_CTL) + CW_CONVQ + 64 * qword;
    LAS int* slot = (LAS int*)(lds + MISC_OFF + 8192);
    const int wave = __builtin_amdgcn_readfirstlane(tid >> 6), lane = tid & 63;
    LAS float* scr = (LAS float*)(lds + wave * 16384);
    for (;;) {
        __syncthreads();
        if (tid == 0) *slot = (int)__hip_atomic_fetch_add(counter, 1u, __ATOMIC_RELAXED, __HIP_MEMORY_SCOPE_AGENT);
        __syncthreads();
        const int base = begin + (*slot) * 16;
        if (base >= end) break;
#pragma unroll 1
        for (int j = 0; j < 2; ++j) { const int it = base + wave * 2 + j; if (it < end) conv_item(a, it, scr, lane); }
    }
}

constexpr int NPHASES = 15;

__device__ __forceinline__ void p0_prologue(const Args& a, LAS unsigned char* lds, int vcu, int G, int tid) {
    unsigned char* ws = a.ws;
    const int wave = __builtin_amdgcn_readfirstlane(tid >> 6), lane = tid & 63;
    const int gw = vcu * NWAVES + wave, NGW = G * NWAVES;
    for (int m = gw; m < T; m += NGW) norm_row(a.in[I_X] + (size_t)m * D, (bf16_t*)(ws + FW_XG) + (size_t)m * D, (float*)(ws + FW_SSQ) + (size_t)m * 16, lane);
    for (int idx = (int)blockIdx.x * NTHR + tid; idx < 2 * 24 * 1024; idx += G * NTHR) {
        const int l = idx / (24 * 1024), j = (idx / 1024) % 24, k = idx & 1023;
        float v = 0.f; if (j < 4) v = a.in[I_WRG][((size_t)l * D + k) * 4 + j]; else if (j < 20) v = a.in[I_WRE][((size_t)l * D + k) * 16 + (j - 4)];
        v *= a.in[I_NFFNG][l * D + k];
        const bf16_t h = f2bf(v), lo = f2bf(v - bf2f(h));
        bf16_t* rt = (bf16_t*)(ws + FW_RT) + (size_t)l * 48 * 1024;
        rt[j * 1024 + k] = h; rt[(24 + j) * 1024 + k] = lo;
    }
    conv_work(a, lds, 0, CV_IN, 0, tid);
}

#define XB_TMO      128
#define XB_XCNT(j)  (256  + 64 * (j))
#define XB_XSUB(j)  (1280 + 64 * (j))
#define XB_XGEN(j)  (2304 + 64 * (j))
#define XB_TOP      3328
#define XB_TOPGEN   3392
#define XCD_BAR_WORDS 3456
#define XB_SPIN_CAP (1u << 18)
__device__ __forceinline__ unsigned xb_ld(unsigned* p)              { return __hip_atomic_load(p, __ATOMIC_RELAXED, __HIP_MEMORY_SCOPE_AGENT); }
__device__ __forceinline__ unsigned xb_add(unsigned* p, unsigned v) { return __hip_atomic_fetch_add(p, v, __ATOMIC_RELAXED, __HIP_MEMORY_SCOPE_AGENT); }
__device__ __forceinline__ unsigned xb_xcc_id() { return (unsigned)__builtin_amdgcn_s_getreg((3 << 11) | 20) & 0xFu; }
#define XB_SPIN(cond, bar) do { unsigned _sp = 0; while (cond) { __builtin_amdgcn_s_sleep(1); \
    if ((++_sp & 255u) == 0u) { if (xb_ld(&(bar)[XB_TMO])) break; if (_sp > XB_SPIN_CAP) { atomicAdd(&(bar)[XB_TMO], 1u); break; } } } } while (0)
struct XcdBarrier { unsigned* bar; unsigned x; volatile LAS unsigned* st; int swave; };
__device__ __forceinline__ XcdBarrier xcd_barrier_post(unsigned* bar, volatile LAS unsigned* st, bool tid0) {
    XcdBarrier b; b.bar = bar; b.x = xb_xcc_id(); b.st = st; b.swave = 0;
    if (tid0) (void)xb_add(&bar[XB_XCNT(b.x)], 1u);
    return b;
}
__device__ __forceinline__ void xcd_barrier_complete(unsigned* bar, unsigned x, unsigned& nloc, unsigned& nx) {
    const unsigned G = gridDim.x * gridDim.y * gridDim.z;
    unsigned sum, cnt, mine, sp = 0u;
    for (;;) {
        sum = 0u; cnt = 0u; mine = 0u;
#pragma unroll
        for (unsigned j = 0; j < 16; ++j) { const unsigned c = xb_ld(&bar[XB_XCNT(j)]); sum += c; cnt += (c > 0u) ? 1u : 0u; mine = (j == x) ? c : mine; }
        if (sum == G) break;
        __builtin_amdgcn_s_sleep(1);
        if ((++sp & 255u) == 0u) { if (xb_ld(&bar[XB_TMO])) break; if (sp > XB_SPIN_CAP) { atomicAdd(&bar[XB_TMO], 1u); break; } }
    }
    nloc = mine > 0u ? mine : 1u; nx = cnt > 0u ? cnt : 1u;
}
__device__ __forceinline__ void xcd_barrier(const XcdBarrier& b) {
    asm volatile("s_waitcnt vmcnt(0)" ::: "memory");
    __syncthreads();
    if (tid_of(b.swave) == 0) {
        unsigned* bar = b.bar;
        __builtin_amdgcn_s_waitcnt(0);
        unsigned nloc = b.st[0], nx = b.st[1];
        if (nloc == 0u) { xcd_barrier_complete(bar, b.x, nloc, nx); b.st[0] = nloc; b.st[1] = nx; }
        const unsigned old = xb_add(&bar[XB_XSUB(b.x)], 1u);
        const unsigned gen = old / nloc;
        if (old + 1u == (gen + 1u) * nloc) {
            __builtin_amdgcn_fence(__ATOMIC_RELEASE, "agent");
            asm volatile("s_waitcnt vmcnt(0)" ::: "memory");
            const unsigned og = xb_add(&bar[XB_TOP], 1u);
            const unsigned tg = og / nx;
            if (og + 1u == (tg + 1u) * nx) xb_add(&bar[XB_TOPGEN], 1u);
            else XB_SPIN(xb_ld(&bar[XB_TOPGEN]) == tg, bar);
            __builtin_amdgcn_fence(__ATOMIC_ACQUIRE, "agent");
            xb_add(&bar[XB_XGEN(b.x)], 1u);
            asm volatile("s_waitcnt vmcnt(0)" ::: "memory");
        } else {
            XB_SPIN(xb_ld(&bar[XB_XGEN(b.x)]) == gen, bar);
            __builtin_amdgcn_fence(__ATOMIC_ACQUIRE, "agent");
            asm volatile("s_waitcnt vmcnt(0)" ::: "memory");
        }
    }
    __syncthreads();
}

#define IN(k) (lo <= (k) && (k) < hi)
#ifdef DBG_TS
#define STAMP(k) do { if (blockIdx.x == 0 && tid_of(swave) == 0) ((unsigned long long*)(args.ws + FW_CTL + 768 * 1024))[(k)] = __builtin_amdgcn_s_memrealtime(); } while (0)
#else
#define STAMP(k) do { } while (0)
#endif
#define SEAM(k) do { if (IN(k) && IN((k) + 1)) xcd_barrier(bar); STAMP((k) + 1); } while (0)
#ifndef DUP_PH
#define DUP_PH -1
#endif
#ifndef MOE_SPLIT
#define MOE_SPLIT(layer, seg) 0
#endif
#define PHASE(k, ...) do { if (IN(k)) { { __VA_ARGS__ } if (DUP_PH == (k)) { xcd_barrier(bar); { __VA_ARGS__ } } } } while (0)
template <int L>
__device__ __forceinline__ void layer_phases(const Args& args, LAS unsigned char* lds, const int lo, const int hi, const int G, const int bx, const int vcu, const XcdBarrier& bar, const int swave) {
    unsigned char* ws = args.ws;
    constexpr int l = L, base = 1 + 7 * L;
    constexpr int Q0b = (L == 0) ? CV_IN : CV_LAYER + CV_IN + CV_OUT + CV_G, Q0e = (L == 0) ? CV_IN + CV_OUT + 2 * CV_G : 2 * CV_LAYER;
    constexpr int Q1b = (L == 0) ? CV_IN + CV_OUT + 2 * CV_G : 0, Q1e = (L == 0) ? CV_LAYER : 0;
    constexpr int Q6b = (L == 0) ? CV_LAYER : 0, Q6e = (L == 0) ? CV_LAYER + CV_IN + CV_OUT + CV_G : 0;
    PHASE(base + 0,
        DenseOrder S; S.init(T, WIN_ROWS, G, bx, ws + FW_XG, 1024, (bf16_t*)(ws + FW_WIN) + (size_t)l * WIN_ROWS * 1024, 1024);
        EpiInProj E{(const float*)(ws + FW_SSQ), (bf16_t*)(ws + FW_PROJ), (float*)(ws + FW_GATES), args.in[I_GATEB] + l * 8};
        gemm_phase<EpiInProj, DenseOrder, false>(lds, 1024, 1024, 16, S, E, swave);
        if (Q0e > Q0b) { int t_ = tid_of(swave); asm volatile("" : "+v"(t_)); conv_work(args, lds, Q0b, Q0e, base + 0, t_); }
    );
    SEAM(base + 0);
    PHASE(base + 1,
        for (int u = bx; u < 256; u += G) { int t_ = tid_of(swave); asm volatile("" : "+v"(t_)); attn_unit(args, l, lds, u, t_); }
#ifdef DUP_ATTN
        if (L == 0) for (int u = bx; u < 256; u += G) { int t_ = tid_of(swave); asm volatile("" : "+v"(t_)); attn_unit(args, l, lds, u, t_); }
#endif
        for (int u = bx; u < 256; u += G) { int t_ = tid_of(swave); asm volatile("" : "+v"(t_)); mlstm_a_unit(args, l, lds, u, t_); }
#ifdef DUP_MA
        if (L == 0) for (int u = bx; u < 256; u += G) { int t_ = tid_of(swave); asm volatile("" : "+v"(t_)); mlstm_a_unit(args, l, lds, u, t_); }
#endif
        if (Q1e > Q1b) { int t_ = tid_of(swave); asm volatile("" : "+v"(t_)); conv_work(args, lds, Q1b, Q1e, base + 1, t_); }
    );
    SEAM(base + 1);
    PHASE(base + 2, for (int u = bx; u < 256; u += G) { int t_ = tid_of(swave); asm volatile("" : "+v"(t_)); mlstm_scan_item(args, lds, u, t_); } );
    SEAM(base + 2);
    PHASE(base + 3, for (int u = bx; u < 256; u += G) { int t_ = tid_of(swave); asm volatile("" : "+v"(t_)); mlstm_c_unit(args, l, lds, u, t_); } );
    SEAM(base + 3);
    PHASE(base + 4,
        DenseOrder S; S.init(T, 1024, G, bx, ws + FW_MIX, 1024, (bf16_t*)(ws + FW_WOUT) + (size_t)l * 1024 * 1024, 1024);
        EpiResid<false, false> E{(bf16_t*)(ws + FW_XG), nullptr, (float*)(ws + FW_SSQ), 0, ws + FW_XB8};
        gemm_phase<EpiResid<false, false>, DenseOrder, false>(lds, 1024, 1024, 16, S, E, swave);
    );
    SEAM(base + 4);
    PHASE(base + 5, int t_ = tid_of(swave); asm volatile("" : "+v"(t_)); route1_phase(args, l, lds, bx, G, t_); );
    SEAM(base + 5);
    PHASE(base + 6,
        LAS int* tb = (LAS int*)(lds + MISC_OFF + 12288);
        if (tid_of(swave) == 0) { int run = 0; const int* bc = (const int*)(ws + FW_CTL) + CW_BCNT + 64 * l;
            for (int b = 0; b < 24; ++b) { const int cb = ld_ctl(bc + b); tb[b] = run; tb[32 + b] = cb; run += (cb + 255) >> 8; }
            tb[24] = run; }
        __syncthreads();
        MoeOrder S; S.ntile = __builtin_amdgcn_readfirstlane(tb[24]); S.nup8 = S.ntile; S.ndn4 = S.ntile; S.pad_ = 0; S.G = G; S.c = vcu; S.tb = tb; S.rowtokb = (const int*)(ws + FW_ROWTOKB); S.xb = (const char*)(ws + FW_XB8);
        S.wgu = (const char*)(ws + FW_WGU + (size_t)l * 16 * 1024 * 1024); S.act = (const char*)(ws + FW_PROJ); S.wd = (const char*)(ws + FW_WD + (size_t)l * 16 * 1024 * 512);
        S.upcnt = (unsigned*)(ws + FW_CTL) + CW_UPCNT + 128 * l;
        EpiMoe<L == 1> E{EpiUp{(bf16_t*)(ws + FW_PROJ), (const float*)(ws + FW_RW), S.upcnt}, EpiResid<true, L == 1>{(bf16_t*)(ws + FW_XG), args.out, (float*)(ws + FW_SSQ), 0, nullptr}};
        _Pragma("unroll 1") for (int seg = 0; seg < 2; ++seg) { S.nup8 = seg ? 0 : S.ntile; S.ndn4 = seg ? S.ntile : 0; S.pad_ = MOE_SPLIT(L, seg); gemm_phase<EpiMoe<L == 1>, MoeOrder, true>(lds, 512, 512, 8, S, E, swave); }
#ifdef DUP_MOE
        if (L == 0) { xcd_barrier(bar); E.dn.dry = 1;
            if (DUP_MOE == 1) { S.upcnt += 512; E.up.upcnt = S.upcnt; }
            if (DUP_MOE == 2) { S.upcnt += 512; E.up.upcnt = S.upcnt; S.ndn4 = 0; }
            if (DUP_MOE == 3) { S.nup8 = 0; }
            gemm_phase<EpiMoe<L == 1>, MoeOrder, true>(lds, 512, 512, 8, S, E, swave); }
#endif
        if (Q6e > Q6b) { int t_ = tid_of(swave); asm volatile("" : "+v"(t_)); conv_work(args, lds, Q6b, Q6e, base + 6, t_); }
    );
    SEAM(base + 6);
}

__global__ void __launch_bounds__(NTHR, 2) fwd(Args args) {
    extern __shared__ __attribute__((aligned(16))) unsigned char lds_raw[];
    LAS unsigned char* lds = (LAS unsigned char*)lds_raw;
    const int G = gridDim.x; const int bx = blockIdx.x; const int vcu = (G % 8 == 0) ? (bx % 8) * (G / 8) + bx / 8 : bx;
    const int lo = args.ph_lo, hi = args.ph_hi;
    const int swave = __builtin_amdgcn_readfirstlane((int)threadIdx.x >> 6);
    volatile LAS unsigned* bst = (volatile LAS unsigned*)(lds + MISC_OFF + 12800);
    if (tid_of(swave) < 2) bst[tid_of(swave)] = 0u;
    __syncthreads();
    XcdBarrier bar; bar.bar = (unsigned*)(args.ws + FW_CTL) + CW_BAR; bar.x = 0; bar.st = bst; bar.swave = swave;
    if (hi - lo > 1) { bar = xcd_barrier_post((unsigned*)(args.ws + FW_CTL) + CW_BAR, bst, tid_of(swave) == 0); bar.swave = swave; }
    STAMP(0);
    PHASE(0, int t_ = tid_of(swave); asm volatile("" : "+v"(t_)); p0_prologue(args, lds, vcu, G, t_); );
    SEAM(0);
#ifdef DUP_BAR
    for (int i = 0; i < 8; ++i) xcd_barrier(bar);
#endif
    layer_phases<0>(args, lds, lo, hi, G, bx, vcu, bar, swave);
    layer_phases<1>(args, lds, lo, hi, G, bx, vcu, bar, swave);
}
#undef IN
#undef SEAM
#undef PHASE
}

extern "C" void kernel_launch(void* const* d_in, const int* in_sizes, int n_in, void* d_out, int out_size, void* d_ws, size_t ws_size, hipStream_t stream) {
    static int grid = 0;
    if (grid == 0) {
        int dev = 0, cus = 0, per_cu = 0;
        if (hipGetDevice(&dev) != hipSuccess || hipDeviceGetAttribute(&cus, hipDeviceAttributeMultiprocessorCount, dev) != hipSuccess) { fprintf(stderr, "kernel_launch: device query failed\n"); grid = -1; return; }
        if (hipFuncSetAttribute((const void*)fk::fwd, hipFuncAttributeMaxDynamicSharedMemorySize, fk::LDS_BYTES) != hipSuccess) { fprintf(stderr, "kernel_launch: hipFuncSetAttribute failed\n"); grid = -1; return; }
        if (hipOccupancyMaxActiveBlocksPerMultiprocessor(&per_cu, (const void*)fk::fwd, fk::NTHR, fk::LDS_BYTES) != hipSuccess || per_cu < 1) { fprintf(stderr, "kernel_launch: occupancy query says %d blocks per CU\n", per_cu); per_cu = 1; }
        (void)hipGetLastError();
        grid = cus;
        fprintf(stderr, "kernel_launch: grid %d, per_cu %d, ws_size %zu\n", grid, per_cu, ws_size);
    }
    if (grid < 0) return;
    const float* x = (const float*)d_in[0];
    const float* rel_bias = (const float*)d_in[1];
    const float* q_norm_g = (const float*)d_in[4];
    const float* k_norm_g = (const float*)d_in[5];
    const float* attn_sink = (const float*)d_in[6];
    const float* conv_w = (const float*)d_in[7];
    const float* conv_b = (const float*)d_in[8];
    const float* mlstm_norm_g = (const float*)d_in[10];
    const float* w_out = (const float*)d_in[11];
    const float* norm_mix_g = (const float*)d_in[2];
    const float* norm_ffn_g = (const float*)d_in[12];
    const float* w_rg = (const float*)d_in[13];
    const float* b_rg = (const float*)d_in[14];
    const float* w_re = (const float*)d_in[15];
    const float* b_re = (const float*)d_in[16];
    const float* w_gate = (const float*)d_in[17];
    const float* w_up = (const float*)d_in[18];
    const float* w_down = (const float*)d_in[19];
    float* out = (float*)d_out;
    unsigned char* ws = (unsigned char*)d_ws;
    bf16_t* XG = (bf16_t*)(ws + fk::FW_XG); float* SSQ = (float*)(ws + fk::FW_SSQ); float* GATES = (float*)(ws + fk::FW_GATES);
    int* RB = (int*)(ws + fk::FW_RB); float* RW = (float*)(ws + fk::FW_RW);
    bf16_t* PROJ = (bf16_t*)(ws + fk::FW_PROJ); bf16_t* MIX = (bf16_t*)(ws + fk::FW_MIX);
    float* QKC = (float*)(ws + fk::FW_XG);
    float* HM = (float*)(ws + 252 * MiB);
    fk::Args a{};
    for (int i = 0; i < 20; ++i) a.in[i] = (const float*)d_in[i];
    a.out = out; a.ws = ws;
    (void)hipMemsetAsync(ws + fk::FW_CTL, 0, 64 * 1024, stream);
    auto run = [&](int lo, int hi) { a.ph_lo = lo; a.ph_hi = hi; hipLaunchKernelGGL(fk::fwd, dim3(grid), dim3(fk::NTHR), fk::LDS_BYTES, stream, a); };
#ifdef MULTI_LAUNCH
    for (int p = 0; p < fk::NPHASES; ++p) run(p, p + 1);
#else
    run(0, fk::NPHASES);
#endif
}
```
